# Optimizing an MI355X kernel written in HIP

```python
import math
import jax, jax.numpy as jnp
from jax import lax
import numpy as np

D_MODEL = 1024
BATCH = 1
SEQ = 16384
DEPTH = 2

GRID_W = 64
CTX_LEN = 256

CONV_W = 256
CONV_K = 31
RET_HEADS = 6
RET_DK = 32
RET_DV = 64
RET_W = RET_HEADS * RET_DV
RET_CHUNK = 128
RET_GN_EPS = 1e-5
MLA_HEADS = 6
MLA_Q_RANK = 192
MLA_KV_RANK = 128
MLA_D_NOPE = 64
MLA_D_ROPE = 32
MLA_D_V = 64
MLA_W = MLA_HEADS * MLA_D_V
MLA_SCALE = (MLA_D_NOPE + MLA_D_ROPE) ** -0.5
Q_BLOCK = 128
MIX_W = CONV_W + RET_W + MLA_W
ROPE_DIM = 32
ROPE_PAIRS = ROPE_DIM // 4
ROPE_BASE = 10000.0
N_EXPERTS = 16
N_GROUPS = 4
EXPERTS_PER_GROUP = N_EXPERTS // N_GROUPS
TOP_K = 2
D_EXPERT = 256
EPS = 1e-6

IN_SIZES = (2 * CONV_W, RET_HEADS * RET_DK, RET_HEADS * RET_DK, RET_W, RET_W, RET_W,
            MLA_Q_RANK, MLA_KV_RANK, MLA_D_ROPE)
IN_COLS = 2 * CONV_W + 2 * RET_HEADS * RET_DK + 3 * RET_W + MLA_Q_RANK + MLA_KV_RANK + MLA_D_ROPE

kernel_name = "hymba_conv_retnet_mla_groupmoe_dit"


def rmsnorm(x, w):
    xf = x.astype(jnp.float32)
    y = xf * lax.rsqrt(jnp.mean(xf * xf, axis=-1, keepdims=True) + EPS)
    return (y * w.astype(jnp.float32)).astype(x.dtype)


def layernorm(x, w, b):
    xf = x.astype(jnp.float32)
    mu = jnp.mean(xf, axis=-1, keepdims=True)
    var = jnp.mean(jnp.square(xf - mu), axis=-1, keepdims=True)
    y = (xf - mu) * lax.rsqrt(var + EPS)
    return (y * w.astype(jnp.float32) + b.astype(jnp.float32)).astype(x.dtype)


def modulate(h, shift, scale):
    return h * (1.0 + scale) + shift


def split_cols(p, sizes):
    offs = np.cumsum(sizes)[:-1].tolist()
    return jnp.split(p, offs, axis=-1)


def rope_tables(rows):
    r, cl = jnp.meshgrid(jnp.arange(rows, dtype=jnp.float32),
                         jnp.arange(GRID_W, dtype=jnp.float32), indexing="ij")
    r = r.reshape(-1)
    cl = cl.reshape(-1)
    inv = ROPE_BASE ** (-jnp.arange(ROPE_PAIRS, dtype=jnp.float32) / ROPE_PAIRS)
    ar = r[:, None, None] * inv
    ac = cl[:, None, None] * inv
    return (jnp.cos(ar), jnp.sin(ar), jnp.cos(ac), jnp.sin(ac))


def apply_rope(x, tabs):
    cos_r, sin_r, cos_c, sin_c = tabs
    m = x.shape[-1] // 4

    def rot(seg, cos, sin):
        a, b = seg[..., :m], seg[..., m:]
        return jnp.concatenate([a * cos - b * sin, a * sin + b * cos], axis=-1)

    y = jnp.concatenate([rot(x[..., :2 * m], cos_r, sin_r), rot(x[..., 2 * m:], cos_c, sin_c)], axis=-1)
    return y.astype(x.dtype)


def conformer_conv(u2, dw, db, ln_w, ln_b):
    a, g = jnp.split(u2, 2, axis=-1)
    u = a * jax.nn.sigmoid(g)
    y = lax.conv_general_dilated(
        u, dw[:, None, :], window_strides=(1,),
        padding=[(CONV_K // 2, CONV_K // 2)],
        dimension_numbers=("NWC", "WIO", "NWC"),
        feature_group_count=CONV_W) + db
    y = layernorm(y, ln_w, ln_b)
    return jax.nn.silu(y)


def retention_chunked(q, k, v, gamma, r0, with_output):
    B_, L, H, dk = q.shape
    dv = v.shape[-1]
    n = L // RET_CHUNK
    qb = q.reshape(B_, n, RET_CHUNK, H, dk)
    kb = k.reshape(B_, n, RET_CHUNK, H, dk)
    vb = v.reshape(B_, n, RET_CHUNK, H, dv)
    log_g = jnp.log(gamma.astype(jnp.float32))
    idx = jnp.arange(RET_CHUNK, dtype=jnp.float32)
    zeta = jnp.exp((RET_CHUNK - 1 - idx)[:, None] * log_g[None, :])
    d_state = jnp.einsum("bnjhd,bnjhe,jh->bnhde", kb, vb, zeta).astype(jnp.float32)
    g_chunk = jnp.exp(RET_CHUNK * log_g)[None, :, None, None]

    def step(r, dr):
        return g_chunk * r + dr, r

    r_final, r_prev = lax.scan(step, r0, jnp.moveaxis(d_state, 1, 0))
    if not with_output:
        return None, r_final
    r_prev = jnp.moveaxis(r_prev, 0, 1)
    diff = idx[:, None] - idx[None, :]
    dmask = jnp.where(diff[None] >= 0,
                      jnp.exp(jnp.maximum(diff, 0.0)[None] * log_g[:, None, None]), 0.0)
    scores = jnp.einsum("bnihd,bnjhd->bnhij", qb, kb) * dmask
    inner = jnp.einsum("bnhij,bnjhe->bnihe", scores, vb)
    xi = jnp.exp((idx + 1.0)[:, None] * log_g[None, :])
    cross = jnp.einsum("bnihd,bnhde->bnihe", qb, r_prev) * xi[None, None, :, :, None]
    return (inner + cross).reshape(B_, L, H, dv), r_final


def retention_dir(q, k, v, gamma, r0, reverse, with_output):
    if reverse:
        q, k, v = jnp.flip(q, 1), jnp.flip(k, 1), jnp.flip(v, 1)
    out, r = retention_chunked(q, k, v, gamma, r0, with_output)
    if reverse and out is not None:
        out = jnp.flip(out, 1)
    return out, r


def head_groupnorm(y):
    yf = y.astype(jnp.float32)
    mu = jnp.mean(yf, axis=-1, keepdims=True)
    var = jnp.mean(jnp.square(yf - mu), axis=-1, keepdims=True)
    return (yf - mu) * lax.rsqrt(var + RET_GN_EPS)


def retention_mixer(pc, pl, tabs, need_ctx):
    def heads(parts, rotate):
        q, k, v, gf, gb = parts
        B_, L, _ = q.shape
        q = q.reshape(B_, L, RET_HEADS, RET_DK)
        k = k.reshape(B_, L, RET_HEADS, RET_DK) * (RET_DK ** -0.5)
        v = v.reshape(B_, L, RET_HEADS, RET_DV)
        gf = gf.reshape(B_, L, RET_HEADS, RET_DV)
        gb = gb.reshape(B_, L, RET_HEADS, RET_DV)
        if rotate:
            q = apply_rope(q, tabs)
            k = apply_rope(k, tabs)
        return q, k, v, gf, gb

    qc, kc, vc, gfc, gbc = heads(pc, False)
    ql, kl, vl, gfl, gbl = heads(pl, True)
    B_, L = ql.shape[0], ql.shape[1]
    gamma_f = 1.0 - 2.0 ** (-5.0 - jnp.arange(RET_HEADS, dtype=jnp.float32))
    gamma_b = gamma_f[::-1]
    r0 = jnp.zeros((B_, RET_HEADS, RET_DK, RET_DV), jnp.float32)
    outs_l, outs_c = [], []
    for reverse, gamma, gate_l, gate_c in ((False, gamma_f, gfl, gfc), (True, gamma_b, gbl, gbc)):
        oc, rc = retention_dir(qc, kc, vc, gamma, r0, reverse, need_ctx)
        ol, _ = retention_dir(ql, kl, vl, gamma, rc, reverse, True)
        outs_l.append(jax.nn.silu(gate_l) * head_groupnorm(ol).astype(gate_l.dtype))
        if need_ctx:
            outs_c.append(jax.nn.silu(gate_c) * head_groupnorm(oc).astype(gate_c.dtype))
    out_l = (outs_l[0] + outs_l[1]).reshape(B_, L, RET_W)
    if not need_ctx:
        return None, out_l
    out_c = (outs_c[0] + outs_c[1]).reshape(B_, qc.shape[1], RET_W)
    return out_c, out_l


def mla_attend(qn, qr, kn, kr, v):
    s = jnp.einsum("bqhd,bkhd->bhqk", qn, kn) + jnp.einsum("bqhd,bkd->bhqk", qr, kr)
    p = jax.nn.softmax(s.astype(jnp.float32) * MLA_SCALE, axis=-1).astype(v.dtype)
    return jnp.einsum("bhqk,bkhd->bqhd", p, v)


def mla_mixer(pc, pl, q_norm_w, w_uq, kv_norm_w, w_ukv, tabs, need_ctx):
    def project(parts, rotate, with_q):
        cq, ckv, kr = parts
        B_, L, _ = ckv.shape
        kv = (rmsnorm(ckv, kv_norm_w) @ w_ukv).reshape(B_, L, MLA_HEADS, MLA_D_NOPE + MLA_D_V)
        kn, v = kv[..., :MLA_D_NOPE], kv[..., MLA_D_NOPE:]
        kr = kr[:, :, None, :]
        if rotate:
            kr = apply_rope(kr, tabs)
        kr = kr[:, :, 0, :]
        if not with_q:
            return None, None, kn, kr, v
        q = (rmsnorm(cq, q_norm_w) @ w_uq).reshape(B_, L, MLA_HEADS, MLA_D_NOPE + MLA_D_ROPE)
        qn, qr = q[..., :MLA_D_NOPE], q[..., MLA_D_NOPE:]
        if rotate:
            qr = apply_rope(qr, tabs)
        return qn, qr, kn, kr, v

    qn_c, qr_c, kn_c, kr_c, v_c = project(pc, False, need_ctx)
    qn_l, qr_l, kn_l, kr_l, v_l = project(pl, True, True)
    kn_all = jnp.concatenate([kn_c, kn_l], axis=1)
    kr_all = jnp.concatenate([kr_c, kr_l], axis=1)
    v_all = jnp.concatenate([v_c, v_l], axis=1)
    B_, L = qn_l.shape[0], qn_l.shape[1]
    nb = L // Q_BLOCK

    def to_blocks(t):
        return jnp.moveaxis(t.reshape(B_, nb, Q_BLOCK, *t.shape[2:]), 1, 0)

    out_l = lax.map(lambda qb: mla_attend(qb[0], qb[1], kn_all, kr_all, v_all),
                    (to_blocks(qn_l), to_blocks(qr_l)))
    out_l = jnp.moveaxis(out_l, 0, 1).reshape(B_, L, MLA_W)
    if not need_ctx:
        return None, out_l
    out_c = mla_attend(qn_c, qr_c, kn_c, kr_c, v_c).reshape(B_, qn_c.shape[1], MLA_W)
    return out_c, out_l


def mixing_sublayer(h_c, h_l, w_in, conv_dw, conv_b, conv_ln_w, conv_ln_b,
                    q_norm_w, w_uq, kv_norm_w, w_ukv, w_out, tabs, need_ctx):
    parts_l = split_cols(h_l @ w_in, IN_SIZES)
    parts_c = split_cols(h_c @ w_in, IN_SIZES)
    conv_l = conformer_conv(parts_l[0], conv_dw, conv_b, conv_ln_w, conv_ln_b)
    ret_c, ret_l = retention_mixer(parts_c[1:6], parts_l[1:6], tabs, need_ctx)
    mla_c, mla_l = mla_mixer(parts_c[6:], parts_l[6:], q_norm_w, w_uq, kv_norm_w, w_ukv, tabs, need_ctx)
    o_l = jnp.concatenate([conv_l, ret_l.astype(h_l.dtype), mla_l], axis=-1) @ w_out
    if not need_ctx:
        return None, o_l
    conv_c = conformer_conv(parts_c[0], conv_dw, conv_b, conv_ln_w, conv_ln_b)
    o_c = jnp.concatenate([conv_c, ret_c.astype(h_c.dtype), mla_c], axis=-1) @ w_out
    return o_c, o_l


def grouped_moe(h, router_w, router_bias, w_gate, w_up, w_down):
    B_, L, D = h.shape
    t = h.reshape(B_ * L, D)
    aff = jax.nn.sigmoid((t @ router_w).astype(jnp.float32))
    sel = aff + router_bias.astype(jnp.float32)
    grp = sel.reshape(-1, N_GROUPS, EXPERTS_PER_GROUP)
    group_score = jnp.sum(lax.top_k(grp, 2)[0], axis=-1)
    best_group = jnp.argmax(group_score, axis=-1)
    in_group = (jnp.arange(N_EXPERTS) // EXPERTS_PER_GROUP)[None, :] == best_group[:, None]
    _, idx = lax.top_k(jnp.where(in_group, sel, -jnp.inf), TOP_K)
    w = jnp.take_along_axis(aff, idx, axis=-1)
    w = w / jnp.sum(w, axis=-1, keepdims=True)
    gates = jnp.sum(jax.nn.one_hot(idx, N_EXPERTS, dtype=jnp.float32) * w[..., None], axis=1)
    out = jnp.zeros((t.shape[0], D), jnp.float32)
    for e in range(N_EXPERTS):
        he = jax.nn.silu(t @ w_gate[e]) * (t @ w_up[e])
        out = out + gates[:, e:e + 1] * (he @ w_down[e])
    return out.astype(h.dtype).reshape(B_, L, D)


def setup_inputs(seed: int = 0) -> dict:
    key = jax.random.key(seed)
    ks = jax.random.split(key, 24)
    f32 = jnp.float32

    def nrm(k, shape, scale):
        return jax.random.normal(k, shape, f32) * scale

    D = D_MODEL
    return {
        "x": nrm(ks[0], (BATCH, SEQ, D), 1.0),
        "c": nrm(ks[1], (BATCH, D), 1.0),
        "ctx": nrm(ks[2], (BATCH, CTX_LEN, D), 1.0),
        "c_ctx": nrm(ks[3], (D,), 1.0),
        "ada_w": nrm(ks[4], (DEPTH, D, 6 * D), 0.5 * D ** -0.5),
        "ada_b": nrm(ks[5], (DEPTH, 6 * D), 0.02),
        "norm1_w": 1.0 + nrm(ks[6], (DEPTH, D), 0.05),
        "norm2_w": 1.0 + nrm(ks[7], (DEPTH, D), 0.05),
        "w_in": nrm(ks[8], (DEPTH, D, IN_COLS), D ** -0.5),
        "conv_dw": nrm(ks[9], (DEPTH, CONV_K, CONV_W), CONV_K ** -0.5),
        "conv_b": nrm(ks[10], (DEPTH, CONV_W), 0.02),
        "conv_ln_w": 1.0 + nrm(ks[11], (DEPTH, CONV_W), 0.05),
        "conv_ln_b": nrm(ks[12], (DEPTH, CONV_W), 0.02),
        "mla_q_norm_w": 1.0 + nrm(ks[13], (DEPTH, MLA_Q_RANK), 0.05),
        "mla_w_uq": nrm(ks[14], (DEPTH, MLA_Q_RANK, MLA_HEADS * (MLA_D_NOPE + MLA_D_ROPE)), MLA_Q_RANK ** -0.5),
        "mla_kv_norm_w": 1.0 + nrm(ks[15], (DEPTH, MLA_KV_RANK), 0.05),
        "mla_w_ukv": nrm(ks[16], (DEPTH, MLA_KV_RANK, MLA_HEADS * (MLA_D_NOPE + MLA_D_V)), MLA_KV_RANK ** -0.5),
        "w_out": nrm(ks[17], (DEPTH, MIX_W, D), MIX_W ** -0.5),
        "router_w": nrm(ks[18], (D, N_EXPERTS), D ** -0.5),
        "router_bias": nrm(ks[19], (N_EXPERTS,), 0.01),
        "moe_w_gate": nrm(ks[20], (DEPTH, N_EXPERTS, D, D_EXPERT), D ** -0.5),
        "moe_w_up": nrm(ks[21], (DEPTH, N_EXPERTS, D, D_EXPERT), D ** -0.5),
        "moe_w_down": nrm(ks[22], (DEPTH, N_EXPERTS, D_EXPERT, D), D_EXPERT ** -0.5),
        "final_norm_w": 1.0 + nrm(ks[23], (D,), 0.05),
    }


def reference(x, c, ctx, c_ctx, ada_w, ada_b, norm1_w, norm2_w, w_in, conv_dw, conv_b,
              conv_ln_w, conv_ln_b, mla_q_norm_w, mla_w_uq, mla_kv_norm_w, mla_w_ukv, w_out,
              router_w, router_bias, moe_w_gate, moe_w_up, moe_w_down, final_norm_w):
    L = x.shape[1]
    ROWS = L // GRID_W
    tabs = rope_tables(ROWS)
    silu_c = jax.nn.silu(c)
    silu_cc = jax.nn.silu(c_ctx)
    xc = ctx
    for l in range(DEPTH):
        need_ctx = l < DEPTH - 1
        mod_l = (silu_c @ ada_w[l] + ada_b[l])[:, None, :]
        mod_c = (silu_cc @ ada_w[l] + ada_b[l])[None, None, :]
        sh1, sc1, g1, sh2, sc2, g2 = jnp.split(mod_l, 6, axis=-1)
        csh1, csc1, cg1, csh2, csc2, cg2 = jnp.split(mod_c, 6, axis=-1)

        h_l = modulate(rmsnorm(x, norm1_w[l]), sh1, sc1)
        h_c = modulate(rmsnorm(xc, norm1_w[l]), csh1, csc1)
        o_c, o_l = mixing_sublayer(h_c, h_l, w_in[l], conv_dw[l], conv_b[l], conv_ln_w[l], conv_ln_b[l],
                                   mla_q_norm_w[l], mla_w_uq[l], mla_kv_norm_w[l], mla_w_ukv[l],
                                   w_out[l], tabs, need_ctx)
        x = x + g1 * o_l
        h_l = modulate(rmsnorm(x, norm2_w[l]), sh2, sc2)
        x = x + g2 * grouped_moe(h_l, router_w, router_bias, moe_w_gate[l], moe_w_up[l], moe_w_down[l])
        if need_ctx:
            xc = xc + cg1 * o_c
            h_c = modulate(rmsnorm(xc, norm2_w[l]), csh2, csc2)
            xc = xc + cg2 * grouped_moe(h_c, router_w, router_bias, moe_w_gate[l], moe_w_up[l], moe_w_down[l])
    return rmsnorm(x, final_norm_w)
```

```cpp
#include <hip/hip_runtime.h>
#include <hip/hip_cooperative_groups.h>
#include <cstdio>
#include <cstdint>
namespace cg = cooperative_groups;

#ifndef MK_FP8
#define MK_FP8 1
#endif
#ifndef MK_CGSYNC
#define MK_CGSYNC 0
#endif
#ifndef MK_MULTI
#define MK_MULTI 0
#endif

#define DI __device__ __forceinline__
#define LAS __attribute__((address_space(3)))
typedef unsigned short bf16_t;
typedef short bf16x8 __attribute__((ext_vector_type(8)));
typedef short s16x4 __attribute__((ext_vector_type(4)));
typedef float f32x4 __attribute__((ext_vector_type(4)));
typedef float f32x16 __attribute__((ext_vector_type(16)));
typedef unsigned u32x4 __attribute__((ext_vector_type(4)));
typedef unsigned u32x2 __attribute__((ext_vector_type(2)));
typedef LAS unsigned char* lptr;

constexpr int D = 1024, SEQ = 16384, CTX = 256, T = SEQ + CTX, DEPTH = 2;
constexpr int NIN = 2400, NINP = 2560;
constexpr int NCH = T / 128;
constexpr int NTHREADS = 512, NWAVES = 8;
constexpr int LDS_BYTES = 147456;
constexpr float QSCALE = 0.10206207261596577f * 1.4426950408889634f;

constexpr size_t WS_CNT  = 0;
constexpr size_t WS_BAR  = 16384;
constexpr size_t WS_CTL_BYTES = 32768;
constexpr size_t WS_TAB  = 32768;
constexpr int    MOD_KS  = 64;
constexpr size_t WS_MODP = WS_TAB + 256 * 16 * 4;
constexpr size_t WS_MOD  = WS_MODP + (size_t)2 * MOD_KS * 2 * 6144 * 4;
constexpr size_t WS_XC   = WS_MOD + (size_t)2 * 2 * 6144 * 4;
constexpr size_t WS_GW   = WS_XC + (size_t)CTX * D * 4;
constexpr size_t WS_LIST = WS_GW + (size_t)T * 2 * 4;
constexpr size_t WS_WIN  = WS_LIST + (size_t)16 * T * 4;
constexpr size_t WS_WOUT = WS_WIN + (size_t)2 * NINP * D * 2;
constexpr size_t WS_WUQ  = WS_WOUT + (size_t)2 * D * D * 2;
constexpr size_t WS_WUKV = WS_WUQ + (size_t)2 * 640 * 192 * 2;
constexpr size_t WS_WGU  = WS_WUKV + (size_t)2 * 768 * 128 * 2;
constexpr size_t WS_WDN  = WS_WGU + (size_t)2 * 16 * 512 * 1024 * 2;
constexpr size_t WS_HA   = WS_WDN + (size_t)2 * 16 * 1024 * 256 * 2;
constexpr size_t SZ_HA   = (size_t)T * D * 2;
constexpr size_t WS_XB   = WS_HA;
constexpr size_t WS_M    = WS_HA + SZ_HA;
constexpr size_t WS_U    = WS_M;
constexpr size_t WS_RQ   = WS_U + (size_t)T * 256 * 2;
constexpr size_t WS_RK   = WS_RQ + (size_t)T * 192 * 2;
constexpr size_t WS_RV   = WS_RK + (size_t)T * 192 * 2;
constexpr size_t WS_GF   = WS_RV + (size_t)T * 384 * 2;
constexpr size_t WS_GB   = WS_GF + (size_t)T * 384 * 2;
constexpr size_t WS_CQ   = WS_GB + (size_t)T * 384 * 2;
constexpr size_t WS_CKV  = WS_CQ + (size_t)T * 192 * 2;
constexpr size_t WS_KR   = WS_CKV + (size_t)T * 128 * 2;
constexpr size_t WS_DS   = WS_KR + (size_t)T * 32 * 2;
constexpr size_t WS_SST  = WS_DS + (size_t)2 * NCH * 6 * 2048 * 4;
constexpr size_t WS_KB   = WS_SST + (size_t)2 * NCH * 6 * 2048 * 4;
constexpr size_t WS_QB   = WS_KB + (size_t)6 * T * 96 * 2;
constexpr size_t WS_VT   = WS_QB + (size_t)6 * T * 96 * 2;
constexpr size_t WS_END  = WS_VT + (size_t)6 * 64 * T * 2;
constexpr size_t WS_PART = WS_END;
constexpr size_t WS_PST  = WS_PART + (size_t)2 * 128 * 256 * 64 * 2;
constexpr size_t WS_END2 = WS_PST + (size_t)2 * 128 * 256 * 2 * 4;
static_assert(WS_END2 <= (size_t)268435456, "workspace map exceeds 256 MiB");
constexpr size_t WS_H2   = WS_KB;
static_assert(WS_H2 + (size_t)T * D * 2 <= WS_VT, "H2 overlay must fit in KB|QB");
constexpr size_t WS_Y    = WS_M;
static_assert(WS_Y + (size_t)T * 2 * D * 2 <= WS_END, "Y overlay");
static_assert(WS_END <= (size_t)268435456, "workspace map exceeds 256 MiB");

struct Params {
    const float *x, *c, *ctx, *c_ctx, *ada_w, *ada_b, *norm1_w, *norm2_w, *w_in, *conv_dw, *conv_b, *conv_ln_w, *conv_ln_b,
                *q_norm_w, *w_uq, *kv_norm_w, *w_ukv, *w_out, *router_w, *router_bias, *moe_g, *moe_u, *moe_d, *final_w;
    float* out; unsigned char* ws; int ph_lo, ph_hi, coop, pad;
};

DI int otid() { int t = threadIdx.x; asm volatile("" : "+v"(t)); return t; }
DI int obid() { int b = blockIdx.x; asm volatile("" : "+s"(b)); return b; }
DI unsigned f2bf(float f) { unsigned u = __float_as_uint(f); return (u + 0x7fffu + ((u >> 16) & 1u)) >> 16; }
typedef float f32x2_t __attribute__((ext_vector_type(2)));
typedef __bf16 bf16x2_t __attribute__((ext_vector_type(2)));
DI unsigned pk2(float lo, float hi) { f32x2_t v = {lo, hi}; bf16x2_t b = __builtin_convertvector(v, bf16x2_t); return __builtin_bit_cast(unsigned, b); }
DI float bf2f(unsigned short h) { return __uint_as_float(((unsigned)h) << 16); }
DI float bflo(unsigned u) { return __uint_as_float(u << 16); }
DI float bfhi(unsigned u) { return __uint_as_float(u & 0xffff0000u); }
DI float fsilu(float x) { return x / (1.f + __expf(-x)); }
DI float fsigm(float x) { return 1.f / (1.f + __expf(-x)); }
DI float xshfl(float v, int m) { return __int_as_float(__builtin_amdgcn_ds_bpermute((((int)otid() & 63) ^ m) << 2, __float_as_int(v))); }
DI float add_x32(float v) { return v + xshfl(v, 32); }
DI float sum_16_32(float v) { v += xshfl(v, 16); return v + xshfl(v, 32); }
DI float wave_sum(float v) {
#pragma unroll
    for (int o = 1; o < 64; o <<= 1) v += xshfl(v, o);
    return v;
}
DI f32x4 zacc4() { f32x4 z = {0.f, 0.f, 0.f, 0.f}; asm volatile("" : "+v"(z)); return z; }
DI f32x4 mfma16(bf16x8 a, bf16x8 b, f32x4 c) { return __builtin_amdgcn_mfma_f32_16x16x32_bf16(a, b, c, 0, 0, 0); }
DI f32x16 mfma32(bf16x8 a, bf16x8 b, f32x16 c) { return __builtin_amdgcn_mfma_f32_32x32x16_bf16(a, b, c, 0, 0, 0); }
DI u32x2 pack4(f32x4 v) { u32x2 r; r.x = pk2(v[0], v[1]); r.y = pk2(v[2], v[3]); return r; }
typedef int i32x8 __attribute__((ext_vector_type(8)));
DI unsigned pk4_fp8(f32x4 v) { int r = 0; r = __builtin_amdgcn_cvt_pk_fp8_f32(v[0], v[1], r, false); r = __builtin_amdgcn_cvt_pk_fp8_f32(v[2], v[3], r, true); return (unsigned)r; }
DI f32x16 mfma_mx(i32x8 a, i32x8 b, f32x16 c) { return __builtin_amdgcn_mfma_scale_f32_32x32x64_f8f6f4(a, b, c, 0, 0, 0, 0x7f7f7f7f, 0, 0x7f7f7f7f); }
DI float gamma_f(int h) { return 1.f - exp2f(-5.f - (float)h); }

DI int rope_perm32(int d) { const int pb = (d >> 3) & 1; const int i = (d & 7) + ((d >> 4) << 3); return pb * 16 + i; }
DI int map_row(int MODE, int n) {
    if (MODE == 1) {
        if (n < 512) { const int ch = n & 255, gate = n >> 8; return ((ch >> 4) << 5) + (gate << 4) + (ch & 15); }
        if (n < 896) { const int o = n - 512; return 512 + (o & ~31) + rope_perm32(o & 31); }
        if (n < 2368) return n;
        return 2368 + rope_perm32(n - 2368);
    } else if (MODE == 2) {
        const int h = n / 96, d = n % 96; return h * 96 + (d < 64 ? d : 64 + rope_perm32(d - 64));
    } else if (MODE == 3) {
        return ((n >> 4) << 5) + (n & 15);
    } else if (MODE == 4) {
        return ((n >> 4) << 5) + 16 + (n & 15);
    }
    return n;
}

DI void transpose_item(int MODE, const float* W, int K, int N, bf16_t* WT, const float* kscale, LAS unsigned* scr, int item, int lane) {
    const int nblk = (N + 63) >> 6, kb = item / nblk, nb = item - kb * nblk, k0 = 64 * kb, n0 = 64 * nb;
    const int c4 = lane & 15, g = lane >> 4;
    const int ncol = n0 + 4 * c4;
    const float* src = W + (size_t)(k0 + 2 * g) * N + (ncol < N ? ncol : 0);
    f32x4 va[8], vb[8];
#pragma unroll
    for (int i = 0; i < 8; ++i) { va[i] = __builtin_nontemporal_load((const f32x4*)(src + (size_t)(8 * i) * N)); vb[i] = __builtin_nontemporal_load((const f32x4*)(src + (size_t)(8 * i + 1) * N)); }
    if (kscale) {
#pragma unroll
        for (int i = 0; i < 8; ++i) {
            const float sa = kscale[k0 + 8 * i + 2 * g], sb = kscale[k0 + 8 * i + 2 * g + 1];
#pragma unroll
            for (int j = 0; j < 4; ++j) { va[i][j] *= sa; vb[i][j] *= sb; }
        }
    }
#pragma unroll
    for (int i = 0; i < 8; ++i)
#pragma unroll
        for (int j = 0; j < 4; ++j) scr[(4 * c4 + j) * 33 + 4 * i + g] = pk2(va[i][j], vb[i][j]);
    asm volatile("s_waitcnt lgkmcnt(0)" ::: "memory");
    const int c = lane & 7;
    const int nlim = N - n0;
#pragma unroll
    for (int jj = 0; jj < 8; ++jj) {
        const int n = (lane >> 3) + 8 * jj; const LAS unsigned* q = scr + n * 33 + 4 * c;
        u32x4 o; o.x = q[0]; o.y = q[1]; o.z = q[2]; o.w = q[3];
        if (n < nlim) *(u32x4*)(WT + (size_t)map_row(MODE, n0 + n) * K + k0 + 8 * c) = o;
    }
    asm volatile("s_waitcnt lgkmcnt(0)" ::: "memory");
}

constexpr int I_IN = 16 * 38, I_OUT = 16 * 16, I_UQ = 3 * 9, I_UKV = 2 * 12, I_G = 16 * 64, I_U = 16 * 64, I_D = 16 * 64, I_ADA = MOD_KS * 24;
constexpr int I_SMALL = I_IN + I_OUT + I_UQ + I_UKV, I_MOE = I_G + I_U + I_D, I_L = I_SMALL + I_MOE + I_ADA;
DI void weight_item(const Params& p, LAS unsigned* scr, int l, int r, int lane) {
    unsigned char* ws = p.ws;
    int mode = 0, K = D, N = D; const float* W; bf16_t* WT; const float* ksc = nullptr;
    if (r < I_IN) { mode = 1; N = NIN; W = p.w_in + (size_t)l * D * NIN; WT = (bf16_t*)(ws + WS_WIN) + (size_t)l * NINP * D; }
    else if ((r -= I_IN) < I_OUT) { W = p.w_out + (size_t)l * D * D; WT = (bf16_t*)(ws + WS_WOUT) + (size_t)l * D * D; }
    else if ((r -= I_OUT) < I_UQ) { mode = 2; K = 192; N = 576; W = p.w_uq + (size_t)l * 192 * 576; WT = (bf16_t*)(ws + WS_WUQ) + (size_t)l * 640 * 192; ksc = p.q_norm_w + l * 192; }
    else if ((r -= I_UQ) < I_UKV) { K = 128; N = 768; W = p.w_ukv + (size_t)l * 128 * 768; WT = (bf16_t*)(ws + WS_WUKV) + (size_t)l * 768 * 128; ksc = p.kv_norm_w + l * 128; }
    else if ((r -= I_UKV) < I_G) { const int e = r / 64; r %= 64; mode = 3; N = 256; W = p.moe_g + ((size_t)l * 16 + e) * 1024 * 256; WT = (bf16_t*)(ws + WS_WGU) + ((size_t)l * 16 + e) * 512 * 1024; }
    else if ((r -= I_G) < I_U) { const int e = r / 64; r %= 64; mode = 4; N = 256; W = p.moe_u + ((size_t)l * 16 + e) * 1024 * 256; WT = (bf16_t*)(ws + WS_WGU) + ((size_t)l * 16 + e) * 512 * 1024; }
    else { r -= I_U; const int e = r / 64; r %= 64; K = 256; N = 1024; W = p.moe_d + ((size_t)l * 16 + e) * 256 * 1024; WT = (bf16_t*)(ws + WS_WDN) + ((size_t)l * 16 + e) * 1024 * 256; }
    transpose_item(mode, W, K, N, WT, ksc, scr, r, lane);
}
DI bool defer_moe_weights() { return DEPTH > 1 && (int)gridDim.x * 5 >= T / 16; }
constexpr int INPROJ_TILES = (T / 256) * (NINP / 256);
DI bool defer_moe_weights0() { return (int)gridDim.x == 256; }
DI int inproj_first_idle() { return INPROJ_TILES - (INPROJ_TILES / 256) * 256; }

DI void phase_p0(const Params& p, lptr lds) {
    const int tid = otid(), lane = tid & 63, wave = __builtin_amdgcn_readfirstlane(tid >> 6);
    const int gw = obid() * NWAVES + wave, NGW = gridDim.x * NWAVES;
    unsigned char* ws = p.ws;
    LAS unsigned* scr = (LAS unsigned*)(lds + wave * 8448);
    static_assert(DEPTH == 2, "item list below is written for two layers");
    const bool defer0 = defer_moe_weights0(), defer1 = defer_moe_weights();
    const int n0 = defer0 ? I_L - I_MOE : I_L, n1 = defer1 ? I_L - I_MOE : I_L;
#pragma unroll 1
    for (int it = gw; it < n0 + n1; it += NGW) {
        const int l = it < n0 ? 0 : 1; int r = it - (l ? n0 : 0);
        if ((l ? defer1 : defer0) && r >= I_SMALL) r += I_MOE;
        if (r < I_L - I_ADA) { weight_item(p, scr, l, r, lane); continue; }
        r -= I_L - I_ADA;
        {
            const int ks = r / 24, cb = r % 24, n = cb * 256 + 4 * lane;
            const float* W = p.ada_w + (size_t)l * D * 6144 + (size_t)(ks * 16) * 6144 + n;
            f32x4 wv[16];
#pragma unroll
            for (int k = 0; k < 16; ++k) wv[k] = __builtin_nontemporal_load((const f32x4*)(W + (size_t)k * 6144));
            f32x4 aL = {0.f, 0.f, 0.f, 0.f}, aC = aL;
#pragma unroll
            for (int k = 0; k < 16; ++k) {
                const float cl = p.c[ks * 16 + k], cc = p.c_ctx[ks * 16 + k];
                const float sl = fsilu(cl), sc = fsilu(cc);
#pragma unroll
                for (int j = 0; j < 4; ++j) { aL[j] += sl * wv[k][j]; aC[j] += sc * wv[k][j]; }
            }
            float* mp = (float*)(ws + WS_MODP) + ((size_t)(l * MOD_KS + ks) * 2) * 6144;
            *(f32x4*)(mp + n) = aL; *(f32x4*)(mp + 6144 + n) = aC;
        }
    }
    {
        const int gt = obid() * NTHREADS + tid, NGT = gridDim.x * NTHREADS;
        const u32x4 z = {0u, 0u, 0u, 0u};
        for (int i = gt; i < 2 * 160 * 128; i += NGT) { const int l = i / (160 * 128), r = i % (160 * 128); *(u32x4*)((bf16_t*)(ws + WS_WIN) + ((size_t)l * NINP + 2400) * D + r * 8) = z; }
        for (int i = gt; i < 2 * 64 * 24; i += NGT) { const int l = i / (64 * 24), r = i % (64 * 24); *(u32x4*)((bf16_t*)(ws + WS_WUQ) + ((size_t)l * 640 + 576) * 192 + r * 8) = z; }
        if (gt < 256 * 8) {
            const int pos = gt >> 3, f = gt & 7;
            const float inv = powf(10000.f, -(float)f / 8.f);
            const float ang = (float)pos * inv;
            float* tab = (float*)(ws + WS_TAB);
            tab[pos * 16 + f] = cosf(ang); tab[pos * 16 + 8 + f] = sinf(ang);
        }
    }
}

DI void phase_p0b(const Params& p) {
    const int gt = obid() * NTHREADS + otid(), NGT = gridDim.x * NTHREADS;
    for (int i = gt; i < 2 * 2 * 6144; i += NGT) {
        const int l = i / 12288, v = (i / 6144) & 1, n = i % 6144;
        float s = p.ada_b[l * 6144 + n];
        const float* mp = (const float*)(p.ws + WS_MODP);
#pragma unroll 16
        for (int ks = 0; ks < MOD_KS; ++ks) s += mp[((size_t)(l * MOD_KS + ks) * 2 + v) * 6144 + n];
        ((float*)(p.ws + WS_MOD))[i] = s;
    }
}
DI bf16_t* catp(const Params& p) { return (bf16_t*)p.out; }
DI bf16_t* xbp(const Params& p) { return (bf16_t*)(p.ws + WS_XB); }
DI f32x4 ld4bf(const bf16_t* q) { const u32x2 u = *(const u32x2*)q; return (f32x4){bflo(u.x), bfhi(u.x), bflo(u.y), bfhi(u.y)}; }
DI f32x4 unpack4(u32x2 u) { return (f32x4){bflo(u.x), bfhi(u.x), bflo(u.y), bfhi(u.y)}; }
DI const float* modp(const Params& p, int l, int v, int chunk) { return (const float*)(p.ws + WS_MOD) + ((size_t)(l * 2 + v) * 6144) + chunk * 1024; }

struct PrepRaw { f32x4 xf[4]; u32x2 xb[4], ya[4], yb[4]; };
DI void phase_prep(const Params& p, int l) {
    const int tid_ = otid(); const int lane = tid_ & 63, wave = tid_ >> 6;
    const int gw = obid() * NWAVES + wave, NGW = gridDim.x * NWAVES;
    auto load_raw = [&](const int t, PrepRaw& r) __attribute__((always_inline)) {
        const bool isctx = t < CTX;
        if (l == 0) {
            const float* src = isctx ? p.ctx + (size_t)t * D : p.x + (size_t)(t - CTX) * D;
#pragma unroll
            for (int j = 0; j < 4; ++j) r.xf[j] = *(const f32x4*)(src + 4 * lane + 256 * j);
        } else {
            const float* X = (const float*)(p.ws + WS_XC) + (size_t)(isctx ? t : 0) * D;
            const bf16_t* XB = xbp(p) + (size_t)(isctx ? 0 : t - CTX) * D;
            const bf16_t* Y0 = (const bf16_t*)(p.ws + WS_Y) + (size_t)(2 * t) * D;
#pragma unroll
            for (int j = 0; j < 4; ++j) {
                const int o = 4 * lane + 256 * j;
                if (isctx) r.xf[j] = *(const f32x4*)(X + o); else r.xb[j] = *(const u32x2*)(XB + o);
                r.ya[j] = *(const u32x2*)(Y0 + o); r.yb[j] = *(const u32x2*)(Y0 + D + o);
            }
        }
    };
    auto process = [&](const int t, PrepRaw& r) __attribute__((always_inline)) {
        const bool isctx = t < CTX; const int v = isctx ? 1 : 0;
        f32x4 xv[4];
        if (l == 0) {
#pragma unroll
            for (int j = 0; j < 4; ++j) xv[j] = r.xf[j];
        } else {
            float* X = (float*)(p.ws + WS_XC) + (size_t)(isctx ? t : 0) * D;
            bf16_t* XB = xbp(p) + (size_t)(isctx ? 0 : t - CTX) * D;
            const float* g2 = modp(p, l - 1, v, 5);
#pragma unroll
            for (int j = 0; j < 4; ++j) {
                const int o = 4 * lane + 256 * j;
                f32x4 xx = isctx ? r.xf[j] : unpack4(r.xb[j]);
                const u32x2 a = r.ya[j], b = r.yb[j];
                const f32x4 g = *(const f32x4*)(g2 + o);
                xx[0] += g[0] * (bflo(a.x) + bflo(b.x)); xx[1] += g[1] * (bfhi(a.x) + bfhi(b.x));
                xx[2] += g[2] * (bflo(a.y) + bflo(b.y)); xx[3] += g[3] * (bfhi(a.y) + bfhi(b.y));
                if (isctx) *(f32x4*)(X + o) = xx;
                else { const u32x2 pk = pack4(xx); *(u32x2*)(XB + o) = pk; xx = unpack4(pk); }
                xv[j] = xx;
            }
        }
        float ss = 0.f;
#pragma unroll
        for (int j = 0; j < 4; ++j) ss += (xv[j][0] * xv[j][0] + xv[j][1] * xv[j][1]) + (xv[j][2] * xv[j][2] + xv[j][3] * xv[j][3]);
        const float rstd = 1.f / sqrtf(wave_sum(ss) * (1.f / D) + 1e-6f);
        const float* nw = p.norm1_w + l * D; const float* sh = modp(p, l, v, 0); const float* sc = modp(p, l, v, 1);
        bf16_t* H = catp(p) + (size_t)t * D;
#pragma unroll
        for (int j = 0; j < 4; ++j) {
            const int o = 4 * lane + 256 * j;
            const f32x4 w = *(const f32x4*)(nw + o), s1 = *(const f32x4*)(sc + o), s0 = *(const f32x4*)(sh + o);
            f32x4 h;
#pragma unroll
            for (int i = 0; i < 4; ++i) h[i] = xv[j][i] * rstd * w[i] * (1.f + s1[i]) + s0[i];
            *(u32x2*)(H + o) = pack4(h);
        }
    };
#pragma unroll 1
    for (int t = gw; t < T; t += 2 * NGW) {
        PrepRaw r0, r1; const int t1 = t + NGW; const bool has1 = t1 < T;
        load_raw(t, r0); if (has1) load_raw(t1, r1);
        process(t, r0); if (has1) process(t1, r1);
    }
}

DI int swz_off(int row, int chunk) { return row * 128 + ((chunk ^ (row & 7)) << 4); }
template <int BM, int BN, int WM, int WN, bool A_LDS, int PF = 1>
struct GemmTile {
    static constexpr int MI = BM / WM / 16, NI = BN / WN / 16;
    static constexpr int AP = (BM + 63) / 64, BP = BN / 64;
    static constexpr int A_BYTES = A_LDS ? 0 : BM * 128, B_BYTES = BN * 128;
    DI static void run(f32x4 (&acc)[MI][NI], lptr stage, const bf16_t* const (&arow)[AP], lptr apanels, const bf16_t* Bt, int ldb, int K) { run(acc, stage, arow, apanels, Bt, ldb, K, [] {}); }
    template <class Pre>
    DI static void run(f32x4 (&acc)[MI][NI], lptr stage, const bf16_t* const (&arow)[AP], lptr apanels, const bf16_t* Bt, int ldb, int K, Pre&& pre) {
        const int tid = otid(), lane = tid & 63, wave = tid >> 6, wm = wave / WN, wn = wave % WN;
        const int lr = tid >> 3, lc = tid & 7;
        lptr As = stage; lptr Bs = stage + A_BYTES;
        const bf16_t* brow[BP];
#pragma unroll
        for (int q = 0; q < BP; ++q) brow[q] = Bt + (size_t)(lr + 64 * q) * ldb + lc * 8;
        u32x4 ra[PF][AP], rb[PF][BP];
        const int nk = K / 64;
#pragma unroll
        for (int s = 0; s < PF; ++s) if (s < nk) {
            if (!A_LDS) {
#pragma unroll
                for (int q = 0; q < AP; ++q) if (BM % 64 == 0 || lr + 64 * q < BM) ra[s][q] = *(const u32x4*)(arow[q] + s * 64);
            }
#pragma unroll
            for (int q = 0; q < BP; ++q) rb[s][q] = *(const u32x4*)(brow[q] + s * 64);
        }
        pre();
        for (int kt0 = 0; kt0 < nk; kt0 += PF) {
#pragma unroll
            for (int s = 0; s < PF; ++s) {
                const int kt = kt0 + s;
                if (PF > 1 && kt >= nk) break;
                __syncthreads();
                if (!A_LDS) {
#pragma unroll
                    for (int q = 0; q < AP; ++q) if (BM % 64 == 0 || lr + 64 * q < BM) *(LAS u32x4*)(As + swz_off(lr + 64 * q, lc)) = ra[s][q];
                }
#pragma unroll
                for (int q = 0; q < BP; ++q) *(LAS u32x4*)(Bs + swz_off(lr + 64 * q, lc)) = rb[s][q];
                __syncthreads();
                if (kt + PF < nk) {
                    if (!A_LDS) {
#pragma unroll
                        for (int q = 0; q < AP; ++q) if (BM % 64 == 0 || lr + 64 * q < BM) ra[s][q] = *(const u32x4*)(arow[q] + (kt + PF) * 64);
                    }
#pragma unroll
                    for (int q = 0; q < BP; ++q) rb[s][q] = *(const u32x4*)(brow[q] + (kt + PF) * 64);
                }
                lptr Ap = A_LDS ? apanels + kt * (BM * 128) : As;
#pragma unroll
                for (int ks = 0; ks < 2; ++ks) {
                    bf16x8 af[MI], bfr[NI];
                    const int ch = 4 * ks + (lane >> 4);
#pragma unroll
                    for (int mi = 0; mi < MI; ++mi) af[mi] = *(const LAS bf16x8*)(Ap + swz_off(wm * (BM / WM) + 16 * mi + (lane & 15), ch));
#pragma unroll
                    for (int ni = 0; ni < NI; ++ni) bfr[ni] = *(const LAS bf16x8*)(Bs + swz_off(wn * (BN / WN) + 16 * ni + (lane & 15), ch));
#pragma unroll
                    for (int mi = 0; mi < MI; ++mi)
#pragma unroll
                        for (int ni = 0; ni < NI; ++ni) acc[mi][ni] = mfma16(bfr[ni], af[mi], acc[mi][ni]);
                }
            }
        }
    }
    template <class Epi>
    DI static void run_panels(f32x4 (&acc)[MI][NI], lptr stage, const bf16_t* const (&arow)[AP], lptr apanels, const bf16_t* Bt, int ldb, int K, int NP, size_t bstride, Epi&& epi) {
        const int tid = otid(), lane = tid & 63, wave = tid >> 6, wm = wave / WN, wn = wave % WN;
        const int lr = tid >> 3, lc = tid & 7;
        lptr As = stage; lptr Bs = stage + A_BYTES;
        const bf16_t* brow[BP];
#pragma unroll
        for (int q = 0; q < BP; ++q) brow[q] = Bt + (size_t)(lr + 64 * q) * ldb + lc * 8;
        u32x4 ra[PF][AP], rb[PF][BP];
        const int nk = K / 64, ntot = nk * NP;
        int lkt = 0; size_t lpo = 0;
        auto fetch = [&](const int s) __attribute__((always_inline)) {
            if (!A_LDS) {
#pragma unroll
                for (int q = 0; q < AP; ++q) if (BM % 64 == 0 || lr + 64 * q < BM) ra[s][q] = *(const u32x4*)(arow[q] + lkt * 64);
            }
#pragma unroll
            for (int q = 0; q < BP; ++q) rb[s][q] = *(const u32x4*)(brow[q] + lpo + lkt * 64);
            if (++lkt == nk) { lkt = 0; lpo += bstride; }
        };
#pragma unroll
        for (int s = 0; s < PF; ++s) if (s < ntot) fetch(s);
        int kt = 0, pn = 0;
        for (int f0 = 0; f0 < ntot; f0 += PF) {
#pragma unroll
            for (int s = 0; s < PF; ++s) {
                const int f = f0 + s;
                if (f >= ntot) break;
                __syncthreads();
                if (!A_LDS) {
#pragma unroll
                    for (int q = 0; q < AP; ++q) if (BM % 64 == 0 || lr + 64 * q < BM) *(LAS u32x4*)(As + swz_off(lr + 64 * q, lc)) = ra[s][q];
                }
#pragma unroll
                for (int q = 0; q < BP; ++q) *(LAS u32x4*)(Bs + swz_off(lr + 64 * q, lc)) = rb[s][q];
                __syncthreads();
                if (f + PF < ntot) fetch(s);
                lptr Ap = A_LDS ? apanels + kt * (BM * 128) : As;
#pragma unroll
                for (int ks = 0; ks < 2; ++ks) {
                    bf16x8 af[MI], bfr[NI];
                    const int ch = 4 * ks + (lane >> 4);
#pragma unroll
                    for (int mi = 0; mi < MI; ++mi) af[mi] = *(const LAS bf16x8*)(Ap + swz_off(wm * (BM / WM) + 16 * mi + (lane & 15), ch));
#pragma unroll
                    for (int ni = 0; ni < NI; ++ni) bfr[ni] = *(const LAS bf16x8*)(Bs + swz_off(wn * (BN / WN) + 16 * ni + (lane & 15), ch));
#pragma unroll
                    for (int mi = 0; mi < MI; ++mi)
#pragma unroll
                        for (int ni = 0; ni < NI; ++ni) acc[mi][ni] = mfma16(bfr[ni], af[mi], acc[mi][ni]);
                }
                if (++kt == nk) {
                    epi(pn, acc);
#pragma unroll
                    for (int mi = 0; mi < MI; ++mi)
#pragma unroll
                        for (int ni = 0; ni < NI; ++ni) acc[mi][ni] = (f32x4){0.f, 0.f, 0.f, 0.f};
                    kt = 0; ++pn;
                }
            }
        }
    }
};
template <int MI, int NI> DI void zero_acc(f32x4 (&acc)[MI][NI]) {
#pragma unroll
    for (int a = 0; a < MI; ++a)
#pragma unroll
        for (int b = 0; b < NI; ++b) acc[a][b] = (f32x4){0.f, 0.f, 0.f, 0.f};
}

DI void rope4(f32x4& a, f32x4& b, const float* tab, int prow, int pcol, int g) {
    const int pos = (g < 2) ? prow : pcol; const int f0 = 4 * (g & 1);
    const f32x4 cs = *(const f32x4*)(tab + pos * 16 + f0), sn = *(const f32x4*)(tab + pos * 16 + 8 + f0);
    const f32x4 ya = a * cs - b * sn, yb = a * sn + b * cs; a = ya; b = yb;
}

namespace pg8 {
#define PG8_LAS __attribute__((address_space(3)))
typedef unsigned short bf16_t;
typedef short bf16x8 __attribute__((ext_vector_type(8)));
typedef float f32x4 __attribute__((ext_vector_type(4)));
typedef unsigned u32x4 __attribute__((ext_vector_type(4)));
constexpr int BM = 256, BK = 64, HALF = 128, HTB = HALF * BK * 2  , STAGE_BYTES = 8 * HTB, NXCD = 8, WGM = 8;

__host__ __device__ __forceinline__ int lds_byte(int r, int c) { const int st = (r >> 4) * 2 + (c >> 5), rr = r & 15, cc = c & 31, ob = rr * 64 + cc * 2; return st * 1024 + (ob ^ (((ob >> 9) & 1) << 5)); }
__host__ __device__ __forceinline__ void stage_rc(int b, int& R, int& C) { const int st = b / 1024, sb = b % 1024, swz = sb ^ (((sb >> 9) & 1) << 5); R = (st >> 1) * 16 + swz / 64; C = (st & 1) * 32 + (swz % 64) / 2; }
__host__ __device__ __forceinline__ int perm32(int rho) { const int n = rho >> 4, i = rho & 15; return 8 * (i >> 2) + 4 * n + (i & 3); }

struct Unit { int pm, pn; };
struct Gemm { const bf16_t* A; const bf16_t* Bt; int M, N, K; };

struct StaticOrder {
    int nM, nN, nwg, G, c;
    __host__ __device__ void init(int M, int N, int G_, int c_) { nM = M / BM; nN = N / BM; nwg = nM * nN; G = G_; c = c_; }
    __host__ __device__ bool next(int i, Unit& u) const {
        const long L = (long)i * G + c; if (L >= nwg) return false;
        int wgid = (int)L; { const int q = nwg / NXCD, r = nwg % NXCD, xcd = wgid % NXCD, off = wgid / NXCD; wgid = (xcd < r ? xcd * (q + 1) : r * (q + 1) + (xcd - r) * q) + off; }
        const int nig = WGM * nN, gid = wgid / nig, fm = gid * WGM, gsz = (nM - fm) < WGM ? (nM - fm) : WGM;
        u.pm = fm + ((wgid % nig) % gsz); u.pn = (wgid % nig) / gsz; return true;
    }
    __device__ __forceinline__ void a_ready(const Unit&) const {}
    __device__ __forceinline__ void done(const Unit&) const {}
};

template <class Epi, class Sched, bool ALIGN_EPI = false, bool SP2 = false>
__device__ __forceinline__ void gemm_phase(PG8_LAS unsigned char* lds, const Gemm g, const Sched& S, const Epi& E) {
    const int tid = otid(), wid = __builtin_amdgcn_readfirstlane(tid >> 6), lane = tid & 63, wr = wid >> 2, wc = wid & 3, fr = lane & 15, fq = lane >> 4;
    const int K = g.K, nt = K / BK;
    unsigned voffA[2], voffB[2];
#pragma unroll
    for (int i = 0; i < 2; ++i) { int R, C; stage_rc(tid * 16 + i * 8192, R, C); const int Rb = Epi::PERM ? ((R & ~31) + perm32(R & 31)) : R;
        voffA[i] = (unsigned)(R * K + C) * 2u; voffB[i] = (unsigned)(Rb * K + C) * 2u; }
    const size_t kstep = (size_t)(BK * 2);
    const size_t hstep = (size_t)HALF * K * 2;
    const size_t tstep = 2 * hstep;
    const unsigned ldsw = (unsigned)wid * 1024u;
    const int aoff = lds_byte(wr * 64 + fr, fq * 8), boff = lds_byte(wc * 32 + fr, fq * 8);
#define PG8_SA(b, h) (((b) * 2 + (h)) * HTB)
#define PG8_SB(b, h) ((4 + (b) * 2 + (h)) * HTB)
#define PG8_STAGE(bufoff, gbase, voff) do { _Pragma("unroll") for (int _i = 0; _i < 2; ++_i) \
        __builtin_amdgcn_global_load_lds((const unsigned*)((const char*)(gbase) + (voff)[_i]), (PG8_LAS unsigned*)(lds + (bufoff) + ldsw + _i * 8192), 16, 0, 0); } while (0)
#define PG8_LDA(dst, b, h) do { _Pragma("unroll") for (int m = 0; m < 4; ++m) _Pragma("unroll") for (int k = 0; k < 2; ++k) dst[m][k] = *(const PG8_LAS bf16x8*)(lds + PG8_SA(b, h) + aoff + m * 2048 + k * 1024); } while (0)
#define PG8_LDB(dst, b, h) do { _Pragma("unroll") for (int n = 0; n < 2; ++n) _Pragma("unroll") for (int k = 0; k < 2; ++k) dst[n][k] = *(const PG8_LAS bf16x8*)(lds + PG8_SB(b, h) + boff + n * 2048 + k * 1024); } while (0)
#define PG8_MMA(ai, bj, At, Bt) do { __builtin_amdgcn_s_setprio(1); _Pragma("unroll") for (int m = 0; m < 4; ++m) _Pragma("unroll") for (int n = 0; n < 2; ++n) _Pragma("unroll") for (int k = 0; k < 2; ++k) \
        acc[ai][bj][m][n] = __builtin_amdgcn_mfma_f32_16x16x32_bf16(Bt[n][k], At[m][k], acc[ai][bj][m][n], 0, 0, 0); __builtin_amdgcn_s_setprio(0); } while (0)
#define PG8_WAIT_V(n) asm volatile("s_waitcnt vmcnt(" #n ")" ::: "memory")
#define PG8_WAIT_L(n) asm volatile("s_waitcnt lgkmcnt(" #n ")" ::: "memory")
#define PG8_BAR __builtin_amdgcn_s_barrier()
#define PG8_SCHED __builtin_amdgcn_sched_barrier(0)
    Unit cur, nxt; int ui = 0;
    if (!S.next(0, cur)) return;
    f32x4 acc[2][2][4][2];
#pragma unroll
    for (int a = 0; a < 2; ++a)
#pragma unroll
        for (int b = 0; b < 2; ++b)
#pragma unroll
            for (int m = 0; m < 4; ++m)
#pragma unroll
                for (int n = 0; n < 2; ++n) acc[a][b][m][n] = (f32x4){0.f, 0.f, 0.f, 0.f};
    bf16x8 At[4][2], B0[2][2], B1[2][2];
    const char* cA = (const char*)g.A + (size_t)cur.pm * tstep; const char* cB = (const char*)g.Bt + (size_t)cur.pn * tstep;
    S.a_ready(cur);
    if constexpr (SP2) {
        PG8_STAGE(PG8_SB(0, 0), cB, voffB); PG8_STAGE(PG8_SB(0, 1), cB + hstep, voffB); PG8_STAGE(PG8_SA(0, 0), cA, voffA); PG8_STAGE(PG8_SA(0, 1), cA + hstep, voffA);
        if (wr == 1) PG8_BAR;
        PG8_WAIT_V(2); PG8_BAR;
        PG8_STAGE(PG8_SB(1, 0), cB + kstep, voffB); PG8_STAGE(PG8_SA(1, 0), cA + kstep, voffA); PG8_STAGE(PG8_SB(1, 1), cB + hstep + kstep, voffB);
        PG8_WAIT_V(6); PG8_BAR;
    } else {
        PG8_STAGE(PG8_SB(0, 0), cB, voffB); PG8_STAGE(PG8_SA(0, 0), cA, voffA); PG8_STAGE(PG8_SB(0, 1), cB + hstep, voffB); PG8_STAGE(PG8_SA(0, 1), cA + hstep, voffA);
        if (wr == 1) PG8_BAR;
        PG8_WAIT_V(4); PG8_BAR;
        PG8_STAGE(PG8_SB(1, 0), cB + kstep, voffB); PG8_STAGE(PG8_SA(1, 0), cA + kstep, voffA); PG8_STAGE(PG8_SB(1, 1), cB + hstep + kstep, voffB);
        PG8_WAIT_V(6); PG8_BAR;
    }
    for (;;) {
        const bool has_next = S.next(ui + 1, nxt);
        const char* nA = has_next ? (const char*)g.A + (size_t)nxt.pm * tstep : cA; const char* nB = has_next ? (const char*)g.Bt + (size_t)nxt.pn * tstep : cB;
        for (int t = 0; t < nt; t += 2) {
            const bool last = (t == nt - 2);
            const char* a1 = cA + (size_t)(t + 1) * kstep;
            const char* a2 = last ? nA : cA + (size_t)(t + 2) * kstep; const char* b2 = last ? nB : cB + (size_t)(t + 2) * kstep;
            const char* a3 = a2 + kstep; const char* b3 = b2 + kstep;
            if (last && has_next) S.a_ready(nxt);
            if constexpr (SP2) {
            PG8_LDB(B0, 0, 0); PG8_LDB(B1, 0, 1); PG8_SCHED; PG8_LDA(At, 0, 0); PG8_STAGE(PG8_SA(1, 1), a1 + hstep, voffA);
            PG8_WAIT_V(8); PG8_WAIT_L(0); PG8_BAR; PG8_MMA(0, 0, At, B0); PG8_MMA(0, 1, At, B1); PG8_BAR; PG8_SCHED;
            PG8_LDA(At, 0, 1); PG8_STAGE(PG8_SB(0, 0), b2, voffB); PG8_STAGE(PG8_SB(0, 1), b2 + hstep, voffB); PG8_STAGE(PG8_SA(0, 0), a2, voffA);
            PG8_WAIT_V(8); PG8_WAIT_L(0); PG8_BAR; PG8_MMA(1, 0, At, B0); PG8_MMA(1, 1, At, B1); PG8_BAR; PG8_SCHED;
            PG8_LDB(B0, 1, 0); PG8_LDB(B1, 1, 1); PG8_SCHED; PG8_LDA(At, 1, 0); PG8_STAGE(PG8_SA(0, 1), a2 + hstep, voffA);
            PG8_WAIT_V(8); PG8_WAIT_L(0); PG8_BAR; PG8_MMA(0, 0, At, B0); PG8_MMA(0, 1, At, B1); PG8_BAR; PG8_SCHED;
            PG8_LDA(At, 1, 1); PG8_STAGE(PG8_SB(1, 0), b3, voffB); PG8_STAGE(PG8_SB(1, 1), b3 + hstep, voffB); PG8_STAGE(PG8_SA(1, 0), a3, voffA);
            PG8_WAIT_V(8); PG8_WAIT_L(0); PG8_BAR; PG8_MMA(1, 0, At, B0); PG8_MMA(1, 1, At, B1); PG8_BAR; PG8_SCHED;
            } else {
            PG8_LDB(B0, 0, 0); PG8_SCHED; PG8_LDA(At, 0, 0); PG8_STAGE(PG8_SA(1, 1), a1 + hstep, voffA);
            PG8_WAIT_L(8); PG8_BAR; PG8_WAIT_L(0); PG8_MMA(0, 0, At, B0); PG8_BAR; PG8_SCHED;
            PG8_LDB(B1, 0, 1); PG8_STAGE(PG8_SB(0, 0), b2, voffB);
            PG8_BAR; PG8_WAIT_L(0); PG8_MMA(0, 1, At, B1); PG8_BAR;
            PG8_LDA(At, 0, 1); PG8_STAGE(PG8_SA(0, 0), a2, voffA);
            PG8_BAR; PG8_WAIT_L(0); PG8_MMA(1, 0, At, B0); PG8_BAR; PG8_SCHED;
            PG8_STAGE(PG8_SB(0, 1), b2 + hstep, voffB);
            PG8_WAIT_V(6); PG8_BAR; PG8_MMA(1, 1, At, B1); PG8_BAR;
            PG8_LDB(B0, 1, 0); PG8_SCHED; PG8_LDA(At, 1, 0); PG8_STAGE(PG8_SA(0, 1), a2 + hstep, voffA);
            PG8_WAIT_L(8); PG8_BAR; PG8_WAIT_L(0); PG8_MMA(0, 0, At, B0); PG8_BAR; PG8_SCHED;
            PG8_LDB(B1, 1, 1); PG8_STAGE(PG8_SB(1, 0), b3, voffB);
            PG8_BAR; PG8_WAIT_L(0); PG8_MMA(0, 1, At, B1); PG8_BAR;
            PG8_LDA(At, 1, 1); PG8_STAGE(PG8_SA(1, 0), a3, voffA);
            PG8_BAR; PG8_WAIT_L(0); PG8_MMA(1, 0, At, B0); PG8_BAR; PG8_SCHED;
            PG8_STAGE(PG8_SB(1, 1), b3 + hstep, voffB);
            PG8_WAIT_V(6); PG8_BAR; PG8_MMA(1, 1, At, B1); PG8_BAR;
            }
        }
        if constexpr (ALIGN_EPI) { if (wr == 0) PG8_BAR; }
        if constexpr (!Epi::AFTER_DRAIN) { E(acc, cur, wr, wc, fr, fq); S.done(cur); }
        if (!has_next) break;
#pragma unroll
        for (int a = 0; a < 2; ++a)
#pragma unroll
            for (int b = 0; b < 2; ++b)
#pragma unroll
                for (int m = 0; m < 4; ++m)
#pragma unroll
                    for (int n = 0; n < 2; ++n) acc[a][b][m][n] = (f32x4){0.f, 0.f, 0.f, 0.f};
        cur = nxt; cA = nA; cB = nB; ++ui;
        if constexpr (ALIGN_EPI) { if (wr == 1) PG8_BAR; }
    }
    PG8_WAIT_V(0);
    if constexpr (!ALIGN_EPI) { if (wr == 0) PG8_BAR; }
    PG8_BAR;
    if constexpr (Epi::AFTER_DRAIN) { E.fused(acc, cur, wr, wc, fr, fq, lds, wid, lane); S.done(cur); }
#undef PG8_SA
#undef PG8_SB
#undef PG8_STAGE
#undef PG8_LDA
#undef PG8_LDB
#undef PG8_MMA
#undef PG8_WAIT_V
#undef PG8_WAIT_L
#undef PG8_BAR
#undef PG8_SCHED
}
}

#ifndef PG8_SP2
#define PG8_SP2 true
#endif
struct EpiInproj {
    static constexpr bool PERM = false, AFTER_DRAIN = false;
    unsigned char* ws;
    DI void operator()(const f32x4 (&acc)[2][2][4][2], const pg8::Unit& u, int wr, int wc, int fr, int fq) const {
        const float* tab = (const float*)(ws + WS_TAB);
        bf16_t* U = (bf16_t*)(ws + WS_U); bf16_t* RQ = (bf16_t*)(ws + WS_RQ); bf16_t* RK = (bf16_t*)(ws + WS_RK); bf16_t* RV = (bf16_t*)(ws + WS_RV);
        bf16_t* GF = (bf16_t*)(ws + WS_GF); bf16_t* GB = (bf16_t*)(ws + WS_GB); bf16_t* CQ = (bf16_t*)(ws + WS_CQ); bf16_t* CKV = (bf16_t*)(ws + WS_CKV); bf16_t* KR = (bf16_t*)(ws + WS_KR);
        const int g = fq;
#pragma unroll
        for (int ai = 0; ai < 2; ++ai)
#pragma unroll
            for (int m = 0; m < 4; ++m) {
                const int t = u.pm * 256 + ai * 128 + wr * 64 + m * 16 + fr;
                const int lat = t - CTX; const bool isl = lat >= 0; const int prow = isl ? (lat >> 6) : 0, pcol = isl ? (lat & 63) : 0;
#pragma unroll
                for (int bj = 0; bj < 2; ++bj) {
                    const int c32 = u.pn * 256 + bj * 128 + wc * 32;
                    f32x4 a = acc[ai][bj][m][0], b = acc[ai][bj][m][1];
                    if (c32 < 512) {
                        f32x4 o;
#pragma unroll
                        for (int j = 0; j < 4; ++j) o[j] = a[j] * fsigm(b[j]);
                        *(u32x2*)(U + (size_t)t * 256 + (c32 >> 1) + 4 * g) = pack4(o);
                    } else if (c32 < 896) {
                        const bool isq = c32 < 704; const int hb = (c32 - (isq ? 512 : 704));
                        if (isl) rope4(a, b, tab, prow, pcol, g);
                        const float sc = isq ? 1.f : 0.17677669529663687f;
                        bf16_t* dst = (isq ? RQ : RK) + (size_t)t * 192 + hb + 4 * g;
                        *(u32x2*)(dst) = pack4(a * sc); *(u32x2*)(dst + 16) = pack4(b * sc);
                    } else if (c32 < 1280) {
                        bf16_t* dst = RV + (size_t)t * 384 + (c32 - 896) + 4 * g; *(u32x2*)(dst) = pack4(a); *(u32x2*)(dst + 16) = pack4(b);
                    } else if (c32 < 2048) {
                        const bool isf = c32 < 1664;
                        bf16_t* dst = (isf ? GF : GB) + (size_t)t * 384 + (c32 - (isf ? 1280 : 1664)) + 4 * g;
                        f32x4 oa, ob;
#pragma unroll
                        for (int j = 0; j < 4; ++j) { oa[j] = fsilu(a[j]); ob[j] = fsilu(b[j]); }
                        *(u32x2*)(dst) = pack4(oa); *(u32x2*)(dst + 16) = pack4(ob);
                    } else if (c32 < 2240) {
                        bf16_t* dst = CQ + (size_t)t * 192 + (c32 - 2048) + 4 * g; *(u32x2*)(dst) = pack4(a); *(u32x2*)(dst + 16) = pack4(b);
                    } else if (c32 < 2368) {
                        bf16_t* dst = CKV + (size_t)t * 128 + (c32 - 2240) + 4 * g; *(u32x2*)(dst) = pack4(a); *(u32x2*)(dst + 16) = pack4(b);
                    } else if (c32 < 2400) {
                        if (isl) rope4(a, b, tab, prow, pcol, g);
                        bf16_t* dst = KR + (size_t)t * 32 + 4 * g; *(u32x2*)(dst) = pack4(a); *(u32x2*)(dst + 16) = pack4(b);
                    }
                }
            }
    }
};
DI void phase_inproj(const Params& p, lptr lds, int l) {
    pg8::Gemm g{catp(p), (const bf16_t*)(p.ws + WS_WIN) + (size_t)l * NINP * D, T, NINP, D};
    pg8::StaticOrder S; S.init(T, NINP, (int)gridDim.x, obid());
    EpiInproj E{p.ws};
    pg8::gemm_phase<EpiInproj, pg8::StaticOrder, true, PG8_SP2>(lds, g, S, E);
    if (l == 0 && defer_moe_weights0() && obid() >= inproj_first_idle()) {
        const int tid = otid(), lane = tid & 63, wave = __builtin_amdgcn_readfirstlane(tid >> 6);
        const int nidle = 256 - inproj_first_idle();
        __syncthreads();
        LAS unsigned* scr = (LAS unsigned*)(lds + wave * 8448);
#pragma unroll 1
        for (int it = (obid() - inproj_first_idle()) * NWAVES + wave; it < I_MOE; it += nidle * NWAVES) weight_item(p, scr, 0, I_SMALL + it, lane);
    }
}

template <bool ISQ>
DI void mla_up_tile(const Params& p, lptr lds, int l, int mt, int nt) {
    typedef GemmTile<256, 128, 4, 2, false, 3> G;
    constexpr int KD = ISQ ? 192 : 128;
    const int tid = otid(), lane = tid & 63, wave = tid >> 6, wm = wave >> 1, wn = wave & 1, il = lane & 15, g = lane >> 4;
    unsigned char* ws = p.ws;
    const bf16_t* A = (const bf16_t*)(ws + (ISQ ? WS_CQ : WS_CKV));
    const bf16_t* W = ISQ ? (const bf16_t*)(ws + WS_WUQ) + (size_t)l * 640 * 192 : (const bf16_t*)(ws + WS_WUKV) + (size_t)l * 768 * 128;
    const float* tab = (const float*)(ws + WS_TAB);
    LAS float* rs = (LAS float*)(lds + 49152);
    const int m0 = mt * 256, n0 = nt * 128;
    __syncthreads();
    f32x4 acc[4][4]; zero_acc(acc);
    const bf16_t* arow[4];
#pragma unroll
    for (int q = 0; q < 4; ++q) arow[q] = A + (size_t)(m0 + (tid >> 3) + 64 * q) * KD + (tid & 7) * 8;
    G::run(acc, lds, arow, lds, W + (size_t)n0 * KD, KD, KD, [&]() __attribute__((always_inline)) {
        if (tid < 256) {
            const bf16_t* r = A + (size_t)(m0 + tid) * KD; float ss = 0.f;
#pragma unroll
            for (int c = 0; c < KD / 8; ++c) {
                const u32x4 v = *(const u32x4*)(r + c * 8);
                ss += bflo(v.x) * bflo(v.x) + bfhi(v.x) * bfhi(v.x) + bflo(v.y) * bflo(v.y) + bfhi(v.y) * bfhi(v.y)
                    + bflo(v.z) * bflo(v.z) + bfhi(v.z) * bfhi(v.z) + bflo(v.w) * bflo(v.w) + bfhi(v.w) * bfhi(v.w);
            }
            rs[tid] = 1.f / sqrtf(ss * (1.f / KD) + 1e-6f);
        }
    });
    __syncthreads();
    bf16_t* QB = (bf16_t*)(ws + WS_QB); bf16_t* KB = (bf16_t*)(ws + WS_KB); bf16_t* VT = (bf16_t*)(ws + WS_VT);
#pragma unroll
    for (int mi = 0; mi < 4; ++mi) {
        const int rloc = wm * 64 + mi * 16 + il; const int t = m0 + rloc;
        const float r = rs[rloc];
        const int lat = t - CTX; const bool isl = lat >= 0; const int prow = isl ? (lat >> 6) : 0, pcol = isl ? (lat & 63) : 0;
#pragma unroll
        for (int u2 = 0; u2 < 2; ++u2) {
            const int c32 = n0 + wn * 64 + 32 * u2;
            f32x4 a = acc[mi][2 * u2] * r, b = acc[mi][2 * u2 + 1] * r;
            if (ISQ) {
                if (c32 < 576) {
                    const int h = c32 / 96, d0 = c32 % 96;
                    if (d0 == 64 && isl) rope4(a, b, tab, prow, pcol, g);
#if MK_FP8
                    unsigned char* dst = (unsigned char*)QB + ((size_t)h * T + t) * 96 + d0 + 4 * g;
                    *(unsigned*)(dst) = pk4_fp8(a * QSCALE); *(unsigned*)(dst + 16) = pk4_fp8(b * QSCALE);
#else
                    bf16_t* dst = QB + ((size_t)h * T + t) * 96 + d0 + 4 * g;
                    *(u32x2*)(dst) = pack4(a * QSCALE); *(u32x2*)(dst + 16) = pack4(b * QSCALE);
#endif
                }
            } else {
                const int h = c32 >> 7, d0 = c32 & 127;
#if MK_FP8
                if (d0 < 64) {
                    unsigned char* dst = (unsigned char*)KB + ((size_t)h * T + t) * 96 + d0 + 4 * g; *(unsigned*)(dst) = pk4_fp8(a); *(unsigned*)(dst + 16) = pk4_fp8(b);
                } else {
                    unsigned char* dst = (unsigned char*)VT + ((size_t)h * T + t) * 64 + (d0 - 64) + 4 * g; *(unsigned*)(dst) = pk4_fp8(a); *(unsigned*)(dst + 16) = pk4_fp8(b);
                }
#else
                if (d0 < 64) {
                    bf16_t* dst = KB + ((size_t)h * T + t) * 96 + d0 + 4 * g; *(u32x2*)(dst) = pack4(a); *(u32x2*)(dst + 16) = pack4(b);
                } else {
                    bf16_t* dst = VT + ((size_t)h * 64 + (d0 - 64) + 4 * g) * T + t;
#pragma unroll
                    for (int j = 0; j < 4; ++j) { dst[(size_t)j * T] = (bf16_t)f2bf(a[j]); dst[(size_t)(16 + j) * T] = (bf16_t)f2bf(b[j]); }
                }
#endif
            }
        }
    }
    if (!ISQ && nt == 0) {
        const bf16_t* KR = (const bf16_t*)(ws + WS_KR);
        for (int i = tid; i < 256 * 4; i += NTHREADS) {
            const int rr = i >> 2, c = i & 3; const u32x4 v = *(const u32x4*)(KR + (size_t)(m0 + rr) * 32 + c * 8);
#if MK_FP8
            u32x2 w; w.x = pk4_fp8((f32x4){bflo(v.x), bfhi(v.x), bflo(v.y), bfhi(v.y)}); w.y = pk4_fp8((f32x4){bflo(v.z), bfhi(v.z), bflo(v.w), bfhi(v.w)});
#pragma unroll
            for (int h = 0; h < 6; ++h) *(u32x2*)((unsigned char*)KB + ((size_t)h * T + m0 + rr) * 96 + 64 + c * 8) = w;
#else
#pragma unroll
            for (int h = 0; h < 6; ++h) *(u32x4*)(KB + ((size_t)h * T + m0 + rr) * 96 + 64 + c * 8) = v;
#endif
        }
    }
}

struct DsRaw { u32x2 va[2], vb[2], ka, kb; };
DI void dstate_load(const Params& p, int c, int h, DsRaw& r) {
    const int tid = otid(); unsigned char* ws = p.ws;
    const bf16_t* RK = (const bf16_t*)(ws + WS_RK); const bf16_t* RV = (const bf16_t*)(ws + WS_RV);
    const int t0 = c * 128;
#pragma unroll
    for (int q = 0; q < 2; ++q) {
        const int idx = tid + 512 * q, rp = idx >> 4, c4 = (idx & 15) * 4;
        r.va[q] = *(const u32x2*)(RV + (size_t)(t0 + 2 * rp) * 384 + h * 64 + c4); r.vb[q] = *(const u32x2*)(RV + (size_t)(t0 + 2 * rp + 1) * 384 + h * 64 + c4);
    }
    { const int rp = tid >> 3, c4 = (tid & 7) * 4;
      r.ka = *(const u32x2*)(RK + (size_t)(t0 + 2 * rp) * 192 + h * 32 + c4); r.kb = *(const u32x2*)(RK + (size_t)(t0 + 2 * rp + 1) * 192 + h * 32 + c4); }
}
DI void dstate_item(const Params& p, lptr lds, int c, int h, DsRaw& raw, bool has_next, int cn, int hn) {
    const int tid = otid(), lane = tid & 63, wave = tid >> 6, il = lane & 15, g = lane >> 4; unsigned char* ws = p.ws;
    constexpr int RS = 272, OVT = 0, OKF = 64 * RS, OKB = OKF + 32 * RS;
    __syncthreads();
#pragma unroll
    for (int q = 0; q < 2; ++q) {
        const int idx = tid + 512 * q, rp = idx >> 4, c4 = (idx & 15) * 4;
        const u32x2 a = raw.va[q], b = raw.vb[q];
        *(LAS unsigned*)(lds + OVT + (c4 + 0) * RS + rp * 4) = (a.x & 0xffffu) | (b.x << 16);
        *(LAS unsigned*)(lds + OVT + (c4 + 1) * RS + rp * 4) = (a.x >> 16) | (b.x & 0xffff0000u);
        *(LAS unsigned*)(lds + OVT + (c4 + 2) * RS + rp * 4) = (a.y & 0xffffu) | (b.y << 16);
        *(LAS unsigned*)(lds + OVT + (c4 + 3) * RS + rp * 4) = (a.y >> 16) | (b.y & 0xffff0000u);
    }
    {
        const int rp = tid >> 3, c4 = (tid & 7) * 4;
        const float lgf = log2f(gamma_f(h)), lgb = log2f(gamma_f(5 - h));
        const float wf0 = exp2f((float)(127 - 2 * rp) * lgf), wf1 = exp2f((float)(126 - 2 * rp) * lgf), wb0 = exp2f((float)(2 * rp) * lgb), wb1 = exp2f((float)(2 * rp + 1) * lgb);
        const u32x2 a = raw.ka, b = raw.kb;
        const float a0 = bflo(a.x), a1 = bfhi(a.x), a2 = bflo(a.y), a3 = bfhi(a.y), b0 = bflo(b.x), b1 = bfhi(b.x), b2 = bflo(b.y), b3 = bfhi(b.y);
        *(LAS unsigned*)(lds + OKF + (c4 + 0) * RS + rp * 4) = pk2(a0 * wf0, b0 * wf1); *(LAS unsigned*)(lds + OKF + (c4 + 1) * RS + rp * 4) = pk2(a1 * wf0, b1 * wf1);
        *(LAS unsigned*)(lds + OKF + (c4 + 2) * RS + rp * 4) = pk2(a2 * wf0, b2 * wf1); *(LAS unsigned*)(lds + OKF + (c4 + 3) * RS + rp * 4) = pk2(a3 * wf0, b3 * wf1);
        *(LAS unsigned*)(lds + OKB + (c4 + 0) * RS + rp * 4) = pk2(a0 * wb0, b0 * wb1); *(LAS unsigned*)(lds + OKB + (c4 + 1) * RS + rp * 4) = pk2(a1 * wb0, b1 * wb1);
        *(LAS unsigned*)(lds + OKB + (c4 + 2) * RS + rp * 4) = pk2(a2 * wb0, b2 * wb1); *(LAS unsigned*)(lds + OKB + (c4 + 3) * RS + rp * 4) = pk2(a3 * wb0, b3 * wb1);
    }
    __syncthreads();
    if (has_next) dstate_load(p, cn, hn, raw);
    const int et = wave & 3, dt = wave >> 2;
    f32x4 af = {0.f, 0.f, 0.f, 0.f}, ab = {0.f, 0.f, 0.f, 0.f};
#pragma unroll
    for (int s4 = 0; s4 < 4; ++s4) {
        const bf16x8 vf = *(const LAS bf16x8*)(lds + OVT + (16 * et + il) * RS + 64 * s4 + 16 * g);
        const bf16x8 kf = *(const LAS bf16x8*)(lds + OKF + (16 * dt + il) * RS + 64 * s4 + 16 * g), kb = *(const LAS bf16x8*)(lds + OKB + (16 * dt + il) * RS + 64 * s4 + 16 * g);
        af = mfma16(vf, kf, af); ab = mfma16(vf, kb, ab);
    }
    float* DS = (float*)(ws + WS_DS);
    *(f32x4*)(DS + (((size_t)0 * NCH + c) * 6 + h) * 2048 + (16 * dt + il) * 64 + 16 * et + 4 * g) = af;
    *(f32x4*)(DS + (((size_t)1 * NCH + c) * 6 + h) * 2048 + (16 * dt + il) * 64 + 16 * et + 4 * g) = ab;
}

DI void conv_item(const Params& p, lptr lds, int l, int tile) {
    const int tid = otid(), lane = tid & 63, wave = tid >> 6; unsigned char* ws = p.ws;
    const bf16_t* U = (const bf16_t*)(ws + WS_U);
    const int t0 = tile * 64; const int seq_lo = (t0 < CTX) ? 0 : CTX, seq_hi = (t0 < CTX) ? CTX : T;
    __syncthreads();
    for (int idx = tid; idx < 94 * 32; idx += NTHREADS) {
        const int row = idx >> 5, ch = idx & 31; const int tok = t0 - 15 + row;
        u32x4 v = {0u, 0u, 0u, 0u};
        if (tok >= seq_lo && tok < seq_hi) v = *(const u32x4*)(U + (size_t)tok * 256 + ch * 8);
        *(LAS u32x4*)(lds + row * 512 + ch * 16) = v;
    }
    const f32x4 bias = *(const f32x4*)(p.conv_b + l * 256 + 4 * lane);
    const f32x4 lw = *(const f32x4*)(p.conv_ln_w + l * 256 + 4 * lane), lb = *(const f32x4*)(p.conv_ln_b + l * 256 + 4 * lane);
    __syncthreads();
    f32x4 acc[8];
#pragma unroll
    for (int i = 0; i < 8; ++i) acc[i] = bias;
#pragma unroll 1
    for (int ps = 0; ps < 4; ++ps) {
        const int k0 = ps * 8;
        f32x4 w[8];
#pragma unroll
        for (int k = 0; k < 8; ++k) w[k] = (k0 + k < 31) ? *(const f32x4*)(p.conv_dw + ((size_t)l * 31 + k0 + k) * 256 + 4 * lane) : (f32x4){0.f, 0.f, 0.f, 0.f};
#pragma unroll
        for (int rq = 0; rq < 15; ++rq) {
            const int rr = k0 + rq;
            if (rr > 37) continue;
            const u32x2 uu = *(const LAS u32x2*)(lds + (wave * 8 + rr) * 512 + lane * 8);
            const f32x4 u4 = {bflo(uu.x), bfhi(uu.x), bflo(uu.y), bfhi(uu.y)};
#pragma unroll
            for (int i = 0; i < 8; ++i) { const int k = rq - i; if (k >= 0 && k < 8) acc[i] += u4 * w[k]; }
        }
        asm volatile("" ::: "memory");
    }
    bf16_t* CAT = catp(p);
#pragma unroll
    for (int i = 0; i < 8; ++i) {
        const f32x4 a = acc[i];
        const float mean = wave_sum((a[0] + a[1]) + (a[2] + a[3])) * (1.f / 256.f);
        const f32x4 dd = a - mean;
        const float var = wave_sum((dd[0] * dd[0] + dd[1] * dd[1]) + (dd[2] * dd[2] + dd[3] * dd[3])) * (1.f / 256.f);
        const float rstd = 1.f / sqrtf(var + 1e-6f);
        f32x4 o;
#pragma unroll
        for (int j = 0; j < 4; ++j) o[j] = fsilu(dd[j] * rstd * lw[j] + lb[j]);
        *(u32x2*)(CAT + (size_t)(t0 + wave * 8 + i) * D + 4 * lane) = pack4(o);
    }
}

DI void phase_pc(const Params& p, lptr lds, int l) {
    constexpr int N_Q = 65 * 5, N_KV = 65 * 6, N_DS = NCH * 6, N_CV = T / 64;
    constexpr int TOTAL = N_Q + N_KV + N_DS + N_CV;
    DsRaw dr; bool dr_valid = false;
    const int G = gridDim.x;
#pragma unroll 1
    for (int it = obid(); it < TOTAL; it += G) {
        int r = it;
        if (r < N_Q) { mla_up_tile<true>(p, lds, l, r / 5, r % 5); continue; } r -= N_Q;
        if (r < N_KV) { mla_up_tile<false>(p, lds, l, r / 6, r % 6); continue; } r -= N_KV;
        if (r < N_DS) {
            if (!dr_valid) dstate_load(p, r / 6, r % 6, dr);
            const int rn = r + G; const bool hn = rn < N_DS;
            dstate_item(p, lds, r / 6, r % 6, dr, hn, hn ? rn / 6 : 0, hn ? rn % 6 : 0); dr_valid = hn; continue;
        }
        r -= N_DS;
        conv_item(p, lds, l, r);
    }
}

#if MK_FP8
constexpr int K8_B = 128 * 112, V8_B = 64 * 144;
DI i32x8 cat8(u32x4 a, u32x4 b) { i32x8 r; r[0] = (int)a.x; r[1] = (int)a.y; r[2] = (int)a.z; r[3] = (int)a.w; r[4] = (int)b.x; r[5] = (int)b.y; r[6] = (int)b.z; r[7] = (int)b.w; return r; }
DI void attn_unit(const Params& p, lptr lds, int h, int q_t0, int kt0, int nkt, int part) {
    const int tid = otid(), lane = tid & 63, wave = tid >> 6, r = lane & 31, hh = lane >> 5;
    unsigned char* ws = p.ws;
    const unsigned char* Qg = ws + WS_QB + ((size_t)h * T + q_t0 + wave * 32 + r) * 96;
    const unsigned char* Kg = ws + WS_KB + (size_t)h * T * 96 + (size_t)kt0 * 12288; const unsigned kgo = tid * 16;
    const unsigned char* Vg = ws + WS_VT + (size_t)h * T * 64 + (size_t)kt0 * 8192; const unsigned vgo = (4 * (tid >> 4)) * 64 + (tid & 15) * 4;
    const u32x4 z4 = {0u, 0u, 0u, 0u};
    const i32x8 q0 = cat8(*(const u32x4*)(Qg + 32 * hh), *(const u32x4*)(Qg + 32 * hh + 16));
    const i32x8 q1 = hh ? cat8(z4, z4) : cat8(*(const u32x4*)(Qg + 64), *(const u32x4*)(Qg + 80));
    f32x16 o0, o1, o2;
#pragma unroll
    for (int i = 0; i < 16; ++i) { o0[i] = 0.f; o1[i] = 0.f; o2[i] = 0.f; }
    float m = 0.f;
    i32x8 ones;
#pragma unroll
    for (int i = 0; i < 8; ++i) ones[i] = 0x38383838;
    f32x16 negm;
#pragma unroll
    for (int i = 0; i < 16; ++i) negm[i] = 0.f;
    u32x4 rk0, rk1 = z4, sk0, sk1 = z4; unsigned rv[4], sv[4];
    const int ka0 = (tid / 6) * 112 + (tid % 6) * 16, ka1 = ((tid + 512) / 6) * 112 + ((tid + 512) % 6) * 16;
    const int kg = tid >> 4, dg = tid & 15;
    const int va = (4 * dg) * 144 + 32 * (kg >> 3) + 16 * (kg & 1) + 4 * ((kg & 7) >> 1);
#define ATT_GLOAD(kt, rk0, rk1, rv) do { const unsigned char* kb_ = Kg + (size_t)(kt) * 12288; rk0 = *(const u32x4*)(kb_ + kgo); if (tid < 256) rk1 = *(const u32x4*)(kb_ + 8192 + kgo); \
        const unsigned char* vb_ = Vg + (size_t)(kt) * 8192; _Pragma("unroll") for (int i_ = 0; i_ < 4; ++i_) rv[i_] = *(const unsigned*)(vb_ + i_ * 64 + vgo); } while (0)
#define ATT_LSTORE(b, rk0, rk1, rv) do { lptr kb_ = lds + (b) * K8_B; *(LAS u32x4*)(kb_ + ka0) = rk0; if (tid < 256) *(LAS u32x4*)(kb_ + ka1) = rk1; \
        const unsigned lo01_ = __builtin_amdgcn_perm(rv[1], rv[0], 0x05010400u), hi01_ = __builtin_amdgcn_perm(rv[1], rv[0], 0x07030602u); \
        const unsigned lo23_ = __builtin_amdgcn_perm(rv[3], rv[2], 0x05010400u), hi23_ = __builtin_amdgcn_perm(rv[3], rv[2], 0x07030602u); \
        lptr vb_ = lds + 3 * K8_B + (b) * V8_B + va; \
        *(LAS unsigned*)(vb_) = __builtin_amdgcn_perm(lo23_, lo01_, 0x05040100u); *(LAS unsigned*)(vb_ + 144) = __builtin_amdgcn_perm(lo23_, lo01_, 0x07060302u); \
        *(LAS unsigned*)(vb_ + 288) = __builtin_amdgcn_perm(hi23_, hi01_, 0x05040100u); *(LAS unsigned*)(vb_ + 432) = __builtin_amdgcn_perm(hi23_, hi01_, 0x07060302u); } while (0)
    __syncthreads();
    ATT_GLOAD(0, rk0, rk1, rv); ATT_GLOAD(1, sk0, sk1, sv);
    ATT_LSTORE(0, rk0, rk1, rv); ATT_LSTORE(1, sk0, sk1, sv);
    __syncthreads();
    i32x8 kn0, kn1;
    { lptr Kb = lds + r * 112 + hh * 32; lptr Kb1 = lds + r * 112 + 64;
      kn0 = cat8(*(const LAS u32x4*)(Kb), *(const LAS u32x4*)(Kb + 16)); kn1 = cat8(*(const LAS u32x4*)(Kb1), *(const LAS u32x4*)(Kb1 + 16)); }
    auto tile = [&](const int kt, const int b) __attribute__((always_inline)) {
        lptr Kb = lds + b * K8_B + r * 112 + hh * 32; lptr Kb1 = lds + b * K8_B + r * 112 + 64;
        f32x16 s[4];
        s[0] = mfma_mx(kn0, q0, negm); s[0] = mfma_mx(kn1, q1, s[0]);
#pragma unroll
        for (int j = 1; j < 4; ++j) {
            const i32x8 k0 = cat8(*(const LAS u32x4*)(Kb + j * 32 * 112), *(const LAS u32x4*)(Kb + j * 32 * 112 + 16));
            const i32x8 k1 = cat8(*(const LAS u32x4*)(Kb1 + j * 32 * 112), *(const LAS u32x4*)(Kb1 + j * 32 * 112 + 16));
            s[j] = mfma_mx(k0, q0, negm); s[j] = mfma_mx(k1, q1, s[j]);
        }
        float mx = fmaxf(fmaxf(s[0][0], s[1][0]), fmaxf(s[2][0], s[3][0]));
#pragma unroll
        for (int i = 1; i < 16; ++i) { mx = fmaxf(fmaxf(mx, s[0][i]), s[1][i]); mx = fmaxf(fmaxf(mx, s[2][i]), s[3][i]); }
        { auto rr = __builtin_amdgcn_permlane32_swap(__float_as_uint(mx), __float_as_uint(mx), false, false); mx = fmaxf(__uint_as_float(rr[0]), __uint_as_float(rr[1])); }
        if (kt == 0 || __any(mx > 8.f)) {
            const float dl = (kt == 0) ? (mx - 6.f) : fmaxf(mx - 6.f, 0.f); const float alpha = __builtin_amdgcn_exp2f(-dl); m += dl;
#pragma unroll
            for (int i = 0; i < 16; ++i) { o0[i] *= alpha; o1[i] *= alpha; o2[i] *= alpha; negm[i] = -m; }
#pragma unroll
            for (int j = 0; j < 4; ++j)
#pragma unroll
                for (int i = 0; i < 16; ++i) s[j][i] -= dl;
        }
#pragma unroll
        for (int j = 0; j < 4; ++j)
#pragma unroll
            for (int i = 0; i < 16; ++i) s[j][i] = __builtin_amdgcn_exp2f(s[j][i]);
        lptr Vb = lds + 3 * K8_B + b * V8_B + r * 144 + hh * 16;
#pragma unroll
        for (int i2 = 0; i2 < 2; ++i2) {
            i32x8 pb;
#pragma unroll
            for (int q = 0; q < 4; ++q) {
                pb[q] = (int)pk4_fp8((f32x4){s[2 * i2][4 * q], s[2 * i2][4 * q + 1], s[2 * i2][4 * q + 2], s[2 * i2][4 * q + 3]});
                pb[4 + q] = (int)pk4_fp8((f32x4){s[2 * i2 + 1][4 * q], s[2 * i2 + 1][4 * q + 1], s[2 * i2 + 1][4 * q + 2], s[2 * i2 + 1][4 * q + 3]});
            }
            const i32x8 v0 = cat8(*(const LAS u32x4*)(Vb + 64 * i2), *(const LAS u32x4*)(Vb + 64 * i2 + 32));
            const i32x8 v1 = cat8(*(const LAS u32x4*)(Vb + 32 * 144 + 64 * i2), *(const LAS u32x4*)(Vb + 32 * 144 + 64 * i2 + 32));
            o0 = mfma_mx(v0, pb, o0); o1 = mfma_mx(v1, pb, o1); o2 = mfma_mx(ones, pb, o2);
        }
    };
    if (__builtin_amdgcn_readfirstlane(wave) >= 4) __builtin_amdgcn_s_setprio(1);
    int b = 0;
#pragma unroll 1
    for (int kt = 0; kt < nkt; ++kt) {
        if (kt + 2 < nkt) ATT_GLOAD(kt + 2, rk0, rk1, rv);
        tile(kt, b);
        const int b1 = (b == 2) ? 0 : b + 1, b2 = (b1 == 2) ? 0 : b1 + 1;
        if (kt + 1 < nkt) { lptr Kb = lds + b1 * K8_B + r * 112 + hh * 32; lptr Kb1 = lds + b1 * K8_B + r * 112 + 64;
            kn0 = cat8(*(const LAS u32x4*)(Kb), *(const LAS u32x4*)(Kb + 16)); kn1 = cat8(*(const LAS u32x4*)(Kb1), *(const LAS u32x4*)(Kb1 + 16)); }
        if (kt + 2 < nkt) ATT_LSTORE(b2, rk0, rk1, rv);
        b = b1;
        __syncthreads();
    }
#undef ATT_GLOAD
#undef ATT_LSTORE
    __builtin_amdgcn_s_setprio(0);
    const float lt = o2[0]; const float inv = 1.f / lt;
    bf16_t* O;
    if (part < 0) O = catp(p) + (size_t)(q_t0 + wave * 32 + r) * D + 640 + 64 * h + 4 * hh;
    else {
        O = (bf16_t*)(ws + WS_PART) + ((size_t)part * 256 + wave * 32 + r) * 64 + 4 * hh;
        if (hh == 0) { float* st = (float*)(ws + WS_PST) + ((size_t)part * 256 + wave * 32 + r) * 2; st[0] = m; st[1] = lt; }
    }
#pragma unroll
    for (int gq = 0; gq < 4; ++gq) {
        f32x4 a = {o0[4 * gq] * inv, o0[4 * gq + 1] * inv, o0[4 * gq + 2] * inv, o0[4 * gq + 3] * inv};
        f32x4 b = {o1[4 * gq] * inv, o1[4 * gq + 1] * inv, o1[4 * gq + 2] * inv, o1[4 * gq + 3] * inv};
        *(u32x2*)(O + 8 * gq) = pack4(a); *(u32x2*)(O + 32 + 8 * gq) = pack4(b);
    }
}
#else
constexpr int KT_B = 128 * 208, VT_B = 64 * 264;
DI void attn_unit(const Params& p, lptr lds, int h, int q_t0, int kt0, int nkt, int part) {
    const int tid = otid(), lane = tid & 63, wave = tid >> 6, r = lane & 31, hh = lane >> 5;
    unsigned char* ws = p.ws;
    const bf16_t* Qg = (const bf16_t*)(ws + WS_QB) + ((size_t)h * T + q_t0 + wave * 32 + r) * 96;
    const unsigned char* Kg = (const unsigned char*)((const bf16_t*)(ws + WS_KB) + (size_t)h * T * 96) + (size_t)kt0 * 24576 + tid * 16;
    const bf16_t* Vg = (const bf16_t*)(ws + WS_VT) + (size_t)h * 64 * T + (size_t)(tid >> 4) * T + (tid & 15) * 8 + (size_t)kt0 * 128;
    bf16x8 qf[6];
#pragma unroll
    for (int ks = 0; ks < 6; ++ks) qf[ks] = *(const bf16x8*)(Qg + 16 * ks + 8 * hh);
    f32x16 o0, o1;
#pragma unroll
    for (int i = 0; i < 16; ++i) { o0[i] = 0.f; o1[i] = 0.f; }
    float m = -1e30f, lsum = 0.f;
    u32x4 rk[3], rv[2];
    int ka[3];
#pragma unroll
    for (int q = 0; q < 3; ++q) { const int idx = tid + 512 * q; ka[q] = (idx / 12) * 208 + (idx % 12) * 16; }
    const int va = (tid >> 4) * 264 + (tid & 15) * 16;
#define ATT_GLOAD(kt) do { const unsigned char* kb_ = Kg + (size_t)(kt) * 24576; \
        _Pragma("unroll") for (int q_ = 0; q_ < 3; ++q_) rk[q_] = *(const u32x4*)(kb_ + q_ * 8192); \
        rv[0] = *(const u32x4*)(Vg + (kt) * 128); rv[1] = *(const u32x4*)(Vg + (size_t)32 * T + (kt) * 128); } while (0)
#define ATT_LSTORE(b) do { lptr kb_ = lds + (b) * KT_B; \
        _Pragma("unroll") for (int q_ = 0; q_ < 3; ++q_) *(LAS u32x4*)(kb_ + ka[q_]) = rk[q_]; \
        lptr vb_ = lds + 2 * KT_B + (b) * VT_B + va; \
        *(LAS u32x2*)(vb_) = (u32x2){rv[0].x, rv[0].y}; *(LAS u32x2*)(vb_ + 8) = (u32x2){rv[0].z, rv[0].w}; \
        *(LAS u32x2*)(vb_ + 32 * 264) = (u32x2){rv[1].x, rv[1].y}; *(LAS u32x2*)(vb_ + 32 * 264 + 8) = (u32x2){rv[1].z, rv[1].w}; } while (0)
    __syncthreads();
    ATT_GLOAD(0); ATT_LSTORE(0);
    __syncthreads();
    for (int kt = 0; kt < nkt; ++kt) {
        const int b = kt & 1;
        if (kt + 1 < nkt) ATT_GLOAD(kt + 1);
        lptr Kb = lds + b * KT_B + r * 208 + hh * 16;
        f32x16 s[4];
#pragma unroll
        for (int j = 0; j < 4; ++j)
#pragma unroll
            for (int i = 0; i < 16; ++i) s[j][i] = 0.f;
#pragma unroll
        for (int ks = 0; ks < 6; ++ks) {
#pragma unroll
            for (int j = 0; j < 4; ++j) { const bf16x8 kf = *(const LAS bf16x8*)(Kb + j * 32 * 208 + ks * 32); s[j] = mfma32(kf, qf[ks], s[j]); }
        }
        float mx = fmaxf(fmaxf(s[0][0], s[1][0]), fmaxf(s[2][0], s[3][0]));
#pragma unroll
        for (int i = 1; i < 16; ++i) { mx = fmaxf(fmaxf(mx, s[0][i]), s[1][i]); mx = fmaxf(fmaxf(mx, s[2][i]), s[3][i]); }
        { auto rr = __builtin_amdgcn_permlane32_swap(__float_as_uint(mx), __float_as_uint(mx), false, false); mx = fmaxf(__uint_as_float(rr[0]), __uint_as_float(rr[1])); }
        if (__any(mx > m)) {
            const float mn = fmaxf(m, mx); const float alpha = __builtin_amdgcn_exp2f(m - mn); m = mn;
            lsum *= alpha;
#pragma unroll
            for (int i = 0; i < 16; ++i) { o0[i] *= alpha; o1[i] *= alpha; }
        }
        float rs0 = 0.f, rs1 = 0.f;
#pragma unroll
        for (int j = 0; j < 4; ++j)
#pragma unroll
            for (int i = 0; i < 16; i += 2) { s[j][i] = __builtin_amdgcn_exp2f(s[j][i] - m); s[j][i + 1] = __builtin_amdgcn_exp2f(s[j][i + 1] - m); rs0 += s[j][i]; rs1 += s[j][i + 1]; }
        lsum += rs0 + rs1;
        lptr Vb = lds + 2 * KT_B + b * VT_B + r * 264 + hh * 8;
#pragma unroll
        for (int j = 0; j < 4; ++j)
#pragma unroll
            for (int sh = 0; sh < 2; ++sh) {
                u32x4 w; w.x = pk2(s[j][8 * sh + 0], s[j][8 * sh + 1]); w.y = pk2(s[j][8 * sh + 2], s[j][8 * sh + 3]); w.z = pk2(s[j][8 * sh + 4], s[j][8 * sh + 5]); w.w = pk2(s[j][8 * sh + 6], s[j][8 * sh + 7]);
                const bf16x8 pb = __builtin_bit_cast(bf16x8, w);
                const int sg = 2 * j + sh;
                const s16x4 l0 = *(const LAS s16x4*)(Vb + 32 * sg), h0 = *(const LAS s16x4*)(Vb + 32 * sg + 16);
                const s16x4 l1 = *(const LAS s16x4*)(Vb + 32 * 264 + 32 * sg), h1 = *(const LAS s16x4*)(Vb + 32 * 264 + 32 * sg + 16);
                const bf16x8 v0 = __builtin_shufflevector(l0, h0, 0, 1, 2, 3, 4, 5, 6, 7), v1 = __builtin_shufflevector(l1, h1, 0, 1, 2, 3, 4, 5, 6, 7);
                o0 = mfma32(v0, pb, o0); o1 = mfma32(v1, pb, o1);
            }
        if (kt + 1 < nkt) ATT_LSTORE(b ^ 1);
        __syncthreads();
    }
#undef ATT_GLOAD
#undef ATT_LSTORE
    const float lt = add_x32(lsum); const float inv = 1.f / lt;
    bf16_t* O;
    if (part < 0) O = catp(p) + (size_t)(q_t0 + wave * 32 + r) * D + 640 + 64 * h + 4 * hh;
    else {
        O = (bf16_t*)(ws + WS_PART) + ((size_t)part * 256 + wave * 32 + r) * 64 + 4 * hh;
        if (hh == 0) { float* st = (float*)(ws + WS_PST) + ((size_t)part * 256 + wave * 32 + r) * 2; st[0] = m; st[1] = lt; }
    }
#pragma unroll
    for (int gq = 0; gq < 4; ++gq) {
        f32x4 a = {o0[4 * gq] * inv, o0[4 * gq + 1] * inv, o0[4 * gq + 2] * inv, o0[4 * gq + 3] * inv};
        f32x4 b = {o1[4 * gq] * inv, o1[4 * gq + 1] * inv, o1[4 * gq + 2] * inv, o1[4 * gq + 3] * inv};
        *(u32x2*)(O + 8 * gq) = pack4(a); *(u32x2*)(O + 32 + 8 * gq) = pack4(b);
    }
}
#endif
DI void attn_merge_item(const Params& p, int su) {
    const int tid = otid(); unsigned char* ws = p.ws;
    const int u = 256 + su, h = u >> 6, q_t0 = CTX + (u & 63) * 256;
    const bf16_t* P0 = (const bf16_t*)(ws + WS_PART) + ((size_t)su * 256) * 64; const bf16_t* P1 = P0 + (size_t)128 * 256 * 64;
    const float* S0 = (const float*)(ws + WS_PST) + ((size_t)su * 256) * 2; const float* S1 = S0 + (size_t)128 * 256 * 2;
#pragma unroll
    for (int q = 0; q < 4; ++q) {
        const int idx = tid + 512 * q, row = idx >> 3, c8 = (idx & 7) * 8;
        const float m0 = S0[row * 2], l0 = S0[row * 2 + 1], m1 = S1[row * 2], l1 = S1[row * 2 + 1];
        const float mm = fmaxf(m0, m1); const float w0 = l0 * __builtin_amdgcn_exp2f(m0 - mm), w1 = l1 * __builtin_amdgcn_exp2f(m1 - mm);
        const float iw = 1.f / (w0 + w1); const float a0 = w0 * iw, a1 = w1 * iw;
        const u32x4 x = *(const u32x4*)(P0 + (size_t)row * 64 + c8), y = *(const u32x4*)(P1 + (size_t)row * 64 + c8);
        u32x4 o;
        o.x = pk2(a0 * bflo(x.x) + a1 * bflo(y.x), a0 * bfhi(x.x) + a1 * bfhi(y.x)); o.y = pk2(a0 * bflo(x.y) + a1 * bflo(y.y), a0 * bfhi(x.y) + a1 * bfhi(y.y));
        o.z = pk2(a0 * bflo(x.z) + a1 * bflo(y.z), a0 * bfhi(x.z) + a1 * bfhi(y.z)); o.w = pk2(a0 * bflo(x.w) + a1 * bflo(y.w), a0 * bfhi(x.w) + a1 * bfhi(y.w));
        *(u32x4*)(catp(p) + (size_t)(q_t0 + row) * D + 640 + 64 * h + c8) = o;
    }
}

DI void scan_item(const Params& p, int item) {
    const int idx = item * NTHREADS + otid();
    const int dir = idx / 12288, rem = idx % 12288, h = rem >> 11, de = rem & 2047, d = de >> 6, e = de & 63;
    const float* DS = (const float*)(p.ws + WS_DS) + (size_t)dir * NCH * 6 * 2048;
    float* SST = (float*)(p.ws + WS_SST) + (size_t)dir * NCH * 6 * 2048;
    const float g128 = exp2f(128.f * log2f(gamma_f(dir ? 5 - h : h)));
    float S = 0.f;
    for (int i0 = 0; i0 < NCH; i0 += 10) {
        float dv[10]; int cc[10];
#pragma unroll
        for (int u = 0; u < 10; ++u) {
            const int i = i0 + u;
            const int c = dir ? (i < 2 ? 1 - i : NCH + 1 - i) : i;
            cc[u] = c; dv[u] = DS[((size_t)c * 6 + h) * 2048 + de];
        }
#pragma unroll
        for (int u = 0; u < 10; ++u) {
            SST[((size_t)cc[u] * 6 + h) * 2048 + de] = S;
            S = S * g128 + dv[u];
        }
    }
}

DI void phase_pd(const Params& p, lptr lds) {
    const int bid = obid(), G = gridDim.x;
#pragma unroll 1
    for (int job = bid; job < 518; job += G) {
        int h, q_t0, kt0 = 0, nkt = T / 128, part = -1;
        if (job < 256) { h = job >> 6; q_t0 = CTX + (job & 63) * 256; }
        else if (job < 512) { const int su = (job - 256) >> 1, half = job & 1, u = 256 + su; h = u >> 6; q_t0 = CTX + (u & 63) * 256; kt0 = half * (T / 256); nkt = T / 256; part = half * 128 + su; }
        else { h = job - 512; q_t0 = 0; nkt = CTX / 128; }
        attn_unit(p, lds, h, q_t0, kt0, nkt, part);
    }
#pragma unroll 1
    for (int it = (bid + G - (8 % G)) % G; it < 48; it += G) scan_item(p, it);
}

struct RetRaw { u32x4 q, k; u32x2 va[2], vb[2]; f32x4 s0, s1; };
DI void retout_load(const Params& p, int c, int h, RetRaw& r) {
    const int tid = otid(); unsigned char* ws = p.ws;
    const bf16_t* RQ = (const bf16_t*)(ws + WS_RQ); const bf16_t* RK = (const bf16_t*)(ws + WS_RK); const bf16_t* RV = (const bf16_t*)(ws + WS_RV);
    const float* SST = (const float*)(ws + WS_SST);
    const int t0 = c * 128;
    { const int row = tid >> 2, ch = tid & 3;
      r.q = *(const u32x4*)(RQ + (size_t)(t0 + row) * 192 + h * 32 + ch * 8); r.k = *(const u32x4*)(RK + (size_t)(t0 + row) * 192 + h * 32 + ch * 8); }
#pragma unroll
    for (int q = 0; q < 2; ++q) {
        const int idx = tid + 512 * q, rp = idx >> 4, c4 = (idx & 15) * 4;
        r.va[q] = *(const u32x2*)(RV + (size_t)(t0 + 2 * rp) * 384 + h * 64 + c4); r.vb[q] = *(const u32x2*)(RV + (size_t)(t0 + 2 * rp + 1) * 384 + h * 64 + c4);
    }
    { const int dir = tid >> 8, tt = tid & 255, dp = tt >> 4, e4 = (tt & 15) * 4;
      const float* S = SST + (((size_t)dir * NCH + c) * 6 + h) * 2048;
      r.s0 = *(const f32x4*)(S + (2 * dp) * 64 + e4); r.s1 = *(const f32x4*)(S + (2 * dp + 1) * 64 + e4); }
}
DI void retout_item(const Params& p, lptr lds, int c, int h, RetRaw& raw, bool has_next, int cn, int hn) {
    const int tid = otid(), lane = tid & 63, wave = tid >> 6, il = lane & 15, g = lane >> 4;
    unsigned char* ws = p.ws;
    constexpr int OQ = 0, OK_ = 10240, OV = 20480, OSF = 37376, OSB = 42496;
    const int t0 = c * 128;
    __syncthreads();
    {
        const int row = tid >> 2, ch = tid & 3;
        *(LAS u32x4*)(lds + OQ + row * 80 + ch * 16) = raw.q;
        *(LAS u32x4*)(lds + OK_ + row * 80 + ch * 16) = raw.k;
    }
#pragma unroll
    for (int q = 0; q < 2; ++q) {
        const int idx = tid + 512 * q, rp = idx >> 4, c4 = (idx & 15) * 4;
        const u32x2 a = raw.va[q], b = raw.vb[q];
        *(LAS unsigned*)(lds + OV + (c4 + 0) * 264 + rp * 4) = (a.x & 0xffffu) | (b.x << 16);
        *(LAS unsigned*)(lds + OV + (c4 + 1) * 264 + rp * 4) = (a.x >> 16) | (b.x & 0xffff0000u);
        *(LAS unsigned*)(lds + OV + (c4 + 2) * 264 + rp * 4) = (a.y & 0xffffu) | (b.y << 16);
        *(LAS unsigned*)(lds + OV + (c4 + 3) * 264 + rp * 4) = (a.y >> 16) | (b.y & 0xffff0000u);
    }
    {
        const int dir = tid >> 8, tt = tid & 255, dp = tt >> 4, e4 = (tt & 15) * 4;
        const f32x4 v0 = raw.s0, v1 = raw.s1;
#pragma unroll
        for (int i = 0; i < 4; ++i) *(LAS unsigned*)(lds + (dir ? OSB : OSF) + (e4 + i) * 80 + dp * 4) = pk2(v0[i], v1[i]);
    }
    __syncthreads();
    if (has_next) retout_load(p, cn, hn, raw);
    const int i = 16 * wave + il;
    const f32x4 zero = {0.f, 0.f, 0.f, 0.f};
    const bf16x8 qf = *(const LAS bf16x8*)(lds + OQ + i * 80 + g * 16);
    f32x4 A[8];
#pragma unroll
    for (int jt = 0; jt < 8; ++jt) { const bf16x8 kf = *(const LAS bf16x8*)(lds + OK_ + (16 * jt + il) * 80 + g * 16); A[jt] = mfma16(kf, qf, zero); }
    asm volatile("s_nop 15\n\ts_nop 15" : "+v"(A[0]), "+v"(A[1]), "+v"(A[2]), "+v"(A[3]), "+v"(A[4]), "+v"(A[5]), "+v"(A[6]), "+v"(A[7]));
    const float lgf = log2f(gamma_f(h)), lgb = log2f(gamma_f(5 - h));
    bf16x8 pf[4], pbk[4];
#pragma unroll
    for (int s = 0; s < 4; ++s) {
        u32x4 wf, wb; float vf[8], vb[8];
#pragma unroll
        for (int hf = 0; hf < 2; ++hf)
#pragma unroll
            for (int r = 0; r < 4; ++r) {
                const int jt = 2 * s + hf, j = 16 * jt + 4 * g + r; const float a = A[jt][r];
                vf[hf * 4 + r] = (j <= i) ? a * exp2f((float)(i - j) * lgf) : 0.f;
                vb[hf * 4 + r] = (j >= i) ? a * exp2f((float)(j - i) * lgb) : 0.f;
            }
        wf.x = pk2(vf[0], vf[1]); wf.y = pk2(vf[2], vf[3]); wf.z = pk2(vf[4], vf[5]); wf.w = pk2(vf[6], vf[7]);
        wb.x = pk2(vb[0], vb[1]); wb.y = pk2(vb[2], vb[3]); wb.z = pk2(vb[4], vb[5]); wb.w = pk2(vb[6], vb[7]);
        pf[s] = __builtin_bit_cast(bf16x8, wf); pbk[s] = __builtin_bit_cast(bf16x8, wb);
    }
    const float xf = exp2f((float)(i + 1) * lgf), xb = exp2f((float)(128 - i) * lgb);
    bf16x8 qff, qfb;
    {
        const u32x4 qr = __builtin_bit_cast(u32x4, qf); u32x4 a, b;
        a.x = pk2(bflo(qr.x) * xf, bfhi(qr.x) * xf); a.y = pk2(bflo(qr.y) * xf, bfhi(qr.y) * xf); a.z = pk2(bflo(qr.z) * xf, bfhi(qr.z) * xf); a.w = pk2(bflo(qr.w) * xf, bfhi(qr.w) * xf);
        b.x = pk2(bflo(qr.x) * xb, bfhi(qr.x) * xb); b.y = pk2(bflo(qr.y) * xb, bfhi(qr.y) * xb); b.z = pk2(bflo(qr.z) * xb, bfhi(qr.z) * xb); b.w = pk2(bflo(qr.w) * xb, bfhi(qr.w) * xb);
        qff = __builtin_bit_cast(bf16x8, a); qfb = __builtin_bit_cast(bf16x8, b);
    }
    f32x4 of[4], ob[4];
#pragma unroll
    for (int et = 0; et < 4; ++et) {
        const bf16x8 sf = *(const LAS bf16x8*)(lds + OSF + (16 * et + il) * 80 + g * 16), sb = *(const LAS bf16x8*)(lds + OSB + (16 * et + il) * 80 + g * 16);
        of[et] = mfma16(sf, qff, zero); ob[et] = mfma16(sb, qfb, zero);
#pragma unroll
        for (int s = 0; s < 4; ++s) {
            const s16x4 lo = *(const LAS s16x4*)(lds + OV + (16 * et + il) * 264 + (32 * s + 4 * g) * 2), hi = *(const LAS s16x4*)(lds + OV + (16 * et + il) * 264 + (32 * s + 16 + 4 * g) * 2);
            const bf16x8 vfr = __builtin_shufflevector(lo, hi, 0, 1, 2, 3, 4, 5, 6, 7);
            of[et] = mfma16(vfr, pf[s], of[et]); ob[et] = mfma16(vfr, pbk[s], ob[et]);
        }
    }
    asm volatile("s_nop 15\n\ts_nop 15" : "+v"(of[0]), "+v"(of[1]), "+v"(of[2]), "+v"(of[3]), "+v"(ob[0]), "+v"(ob[1]), "+v"(ob[2]), "+v"(ob[3]));
    float sf_ = 0.f, sb_ = 0.f;
#pragma unroll
    for (int et = 0; et < 4; ++et) { sf_ += (of[et][0] + of[et][1]) + (of[et][2] + of[et][3]); sb_ += (ob[et][0] + ob[et][1]) + (ob[et][2] + ob[et][3]); }
    sf_ = sum_16_32(sf_); sb_ = sum_16_32(sb_);
    const float muf = sf_ * (1.f / 64.f), mub = sb_ * (1.f / 64.f);
    float qf_ = 0.f, qb_ = 0.f;
#pragma unroll
    for (int et = 0; et < 4; ++et)
#pragma unroll
        for (int r = 0; r < 4; ++r) { const float a = of[et][r] - muf, b = ob[et][r] - mub; qf_ += a * a; qb_ += b * b; }
    qf_ = sum_16_32(qf_); qb_ = sum_16_32(qb_);
    const float rf = 1.f / sqrtf(qf_ * (1.f / 64.f) + 1e-5f), rb = 1.f / sqrtf(qb_ * (1.f / 64.f) + 1e-5f);
    const int t = t0 + i;
    const bf16_t* GF = (const bf16_t*)(ws + WS_GF) + (size_t)t * 384 + 64 * h + 4 * g; const bf16_t* GB = (const bf16_t*)(ws + WS_GB) + (size_t)t * 384 + 64 * h + 4 * g;
    bf16_t* O = catp(p) + (size_t)t * D + 256 + 64 * h + 4 * g;
#pragma unroll
    for (int et = 0; et < 4; ++et) {
        const u32x2 a = *(const u32x2*)(GF + 16 * et), b = *(const u32x2*)(GB + 16 * et);
        f32x4 o;
        o[0] = bflo(a.x) * (of[et][0] - muf) * rf + bflo(b.x) * (ob[et][0] - mub) * rb;
        o[1] = bfhi(a.x) * (of[et][1] - muf) * rf + bfhi(b.x) * (ob[et][1] - mub) * rb;
        o[2] = bflo(a.y) * (of[et][2] - muf) * rf + bflo(b.y) * (ob[et][2] - mub) * rb;
        o[3] = bfhi(a.y) * (of[et][3] - muf) * rf + bfhi(b.y) * (ob[et][3] - mub) * rb;
        *(u32x2*)(O + 16 * et) = pack4(o);
    }
}
DI void phase_pe(const Params& p, lptr lds) {
    const int G = gridDim.x;
    RetRaw raw;
    int it = obid();
    if (it < NCH * 6) retout_load(p, it / 6, it % 6, raw);
#pragma unroll 1
    for (; it < NCH * 6 + 128; it += G) {
        if (it < NCH * 6) { const int nx = it + G; const bool hn = nx < NCH * 6; retout_item(p, lds, it / 6, it % 6, raw, hn, hn ? nx / 6 : 0, hn ? nx % 6 : 0); }
        else attn_merge_item(p, it - NCH * 6);
    }
}

template <int BM, int WMv, int WNv>
DI void outproj_tile(const Params& p, lptr lds, int l, int m0, int n0) {
    typedef GemmTile<BM, 128, WMv, WNv, false> G;
    constexpr int MI = G::MI, NI = G::NI;
    const int tid = otid(), lane = tid & 63, wave = tid >> 6, wm = wave / WNv, wn = wave % WNv, il = lane & 15, g = lane >> 4;
    unsigned char* ws = p.ws;
    const bf16_t* CAT = catp(p); const bf16_t* W = (const bf16_t*)(ws + WS_WOUT) + (size_t)l * D * D;
    f32x4 acc[MI][NI]; zero_acc(acc);
    const bf16_t* arow[G::AP];
#pragma unroll
    for (int q = 0; q < G::AP; ++q) arow[q] = CAT + (size_t)(m0 + (tid >> 3) + 64 * q) * D + (tid & 7) * 8;
    G::run(acc, lds, arow, lds, W + (size_t)n0 * D, D, D);
    const int v = (m0 < CTX) ? 1 : 0;
    const float* g1 = modp(p, l, v, 2);
#pragma unroll
    for (int mi = 0; mi < MI; ++mi) {
        const int t = m0 + wm * (BM / WMv) + mi * 16 + il;
        if (t < CTX) {
            float* dst = (float*)(ws + WS_XC) + (size_t)t * D; const float* src = (l == 0) ? p.ctx + (size_t)t * D : dst;
#pragma unroll
            for (int ni = 0; ni < NI; ++ni) {
                const int col = n0 + wn * (128 / WNv) + 16 * ni + 4 * g;
                const f32x4 r = *(const f32x4*)(src + col), gg = *(const f32x4*)(g1 + col);
                *(f32x4*)(dst + col) = r + gg * acc[mi][ni];
            }
        } else {
            bf16_t* dst = xbp(p) + (size_t)(t - CTX) * D;
#pragma unroll
            for (int ni = 0; ni < NI; ++ni) {
                const int col = n0 + wn * (128 / WNv) + 16 * ni + 4 * g;
                const f32x4 r = (l == 0) ? *(const f32x4*)(p.x + (size_t)(t - CTX) * D + col) : ld4bf(dst + col), gg = *(const f32x4*)(g1 + col);
                *(u32x2*)(dst + col) = pack4(r + gg * acc[mi][ni]);
            }
        }
    }
}
struct EpiOutproj {
    static constexpr bool PERM = false, AFTER_DRAIN = false;
    const float* src32; bf16_t* xb; const float* g1;
    DI void operator()(const f32x4 (&acc)[2][2][4][2], const pg8::Unit& u, int wr, int wc, int fr, int fq) const {
#pragma unroll
        for (int ai = 0; ai < 2; ++ai)
#pragma unroll
            for (int m = 0; m < 4; ++m) {
                const size_t ro = (size_t)(u.pm * 256 + ai * 128 + wr * 64 + m * 16 + fr) * D;
#pragma unroll
                for (int bj = 0; bj < 2; ++bj)
#pragma unroll
                    for (int n = 0; n < 2; ++n) {
                        const int col = u.pn * 256 + bj * 128 + wc * 32 + 16 * n + 4 * fq;
                        const f32x4 r = src32 ? *(const f32x4*)(src32 + ro + col) : ld4bf(xb + ro + col), gg = *(const f32x4*)(g1 + col);
                        *(u32x2*)(xb + ro + col) = pack4(r + gg * acc[ai][bj][m][n]);
                    }
            }
    }
};
DI void phase_outproj(const Params& p, lptr lds, int l) {
    {
        pg8::Gemm g{catp(p) + (size_t)CTX * D, (const bf16_t*)(p.ws + WS_WOUT) + (size_t)l * D * D, SEQ, D, D};
        pg8::StaticOrder S; S.init(SEQ, D, (int)gridDim.x, obid());
        EpiOutproj E{(l == 0) ? p.x : nullptr, xbp(p), modp(p, l, 0, 2)};
        pg8::gemm_phase<EpiOutproj, pg8::StaticOrder, false, PG8_SP2>(lds, g, S, E);
    }
    if (l != DEPTH - 1) {
        for (int c = obid(); c < 32; c += gridDim.x) outproj_tile<64, 1, 8>(p, lds, l, (c >> 3) * 64, (c & 7) * 128);
    }
}

DI void phase_router(const Params& p, lptr lds, int l, int dummy = 0) {
    const int tid = otid(), lane = tid & 63, wave = tid >> 6, il = lane & 15, g = lane >> 4; unsigned char* ws = p.ws;
    constexpr int RWS = 2064;
    constexpr int O_RWH = 0, O_RWL = 16 * RWS, O_WC = 2 * 16 * RWS, O_SH = O_WC + 2 * 1024 * 4, O_CNT = O_SH + 2 * 1024 * 4;
    __syncthreads();
    {
#pragma unroll
        for (int j = 0; j < 4; ++j) {
            const int it = tid + 512 * j, kp = it >> 2, e0 = (it & 3) * 4;
            const f32x4 va = *(const f32x4*)(p.router_w + (size_t)(2 * kp) * 16 + e0), vb = *(const f32x4*)(p.router_w + (size_t)(2 * kp + 1) * 16 + e0);
#pragma unroll
            for (int q = 0; q < 4; ++q) {
                const unsigned ha = f2bf(va[q]), hb = f2bf(vb[q]);
                const float la = va[q] - __uint_as_float(ha << 16), lb = vb[q] - __uint_as_float(hb << 16);
                *(LAS unsigned*)(lds + O_RWH + (e0 + q) * RWS + kp * 4) = ha | (hb << 16);
                *(LAS unsigned*)(lds + O_RWL + (e0 + q) * RWS + kp * 4) = pk2(la, lb);
            }
        }
        const float* nw = p.norm2_w + l * D;
#pragma unroll
        for (int j = 0; j < 4; ++j) { const int i = tid + 512 * j, v = i >> 10, k = i & 1023;
            *(LAS float*)(lds + O_WC + i * 4) = nw[k] * (1.f + modp(p, l, v, 4)[k]); *(LAS float*)(lds + O_SH + i * 4) = modp(p, l, v, 3)[k]; }
        if (tid < 16) *(LAS int*)(lds + O_CNT + tid * 4) = 0;
    }
    __syncthreads();
    if (l == DEPTH - 2 && defer_moe_weights() && __builtin_amdgcn_readfirstlane(wave) >= 5) {
        const int w5 = __builtin_amdgcn_readfirstlane(wave) - 5;
        LAS unsigned* scr = (LAS unsigned*)(lds + 90112 + w5 * 8448);
#pragma unroll 1
        for (int it = w5 * (int)gridDim.x + obid(); it < I_MOE; it += 3 * (int)gridDim.x) weight_item(p, scr, DEPTH - 1, I_SMALL + it, lane);
    }
    int* CNT = (int*)(ws + WS_CNT) + (l + 2 * dummy) * 1024; int* LIST = (int*)(ws + (dummy ? WS_PART : WS_LIST)); float* GW = (float*)(ws + (dummy ? WS_PART + (2u << 20) : WS_GW));
    const int g_lo = (l == DEPTH - 1) ? CTX / 16 : 0, ngroups = T / 16 - g_lo;
    const int gi = obid() + (int)gridDim.x * wave;
    int se0 = 0, se1 = 0, stok = -1, q0 = 0, q1 = 0; float sw0 = 0.f, sw1 = 0.f;
    if (gi < ngroups) {
        const int t = (g_lo + gi) * 16 + il; const bool isctx = t < CTX; const int v = isctx ? 1 : 0;
        const float* X = (const float*)(ws + WS_XC) + (size_t)(isctx ? t : 0) * D + 8 * g;
        const bf16_t* XB = xbp(p) + (size_t)(isctx ? 0 : t - CTX) * D + 8 * g;
        bf16_t* H = (dummy ? catp(p) : (bf16_t*)(ws + WS_H2)) + (size_t)t * D + 8 * g;
        f32x4 acc = zacc4();
        lptr wcp = lds + O_WC + (v * 1024 + 8 * g) * 4; lptr shp = lds + O_SH + (v * 1024 + 8 * g) * 4;
        lptr rwh = lds + O_RWH + il * RWS + 16 * g; lptr rwl = lds + O_RWL + il * RWS + 16 * g;
        auto sq8 = [](const f32x4 a, const f32x4 b) __attribute__((always_inline)) { return (a[0] * a[0] + a[1] * a[1]) + (a[2] * a[2] + a[3] * a[3]) + (b[0] * b[0] + b[1] * b[1]) + (b[2] * b[2] + b[3] * b[3]); };
        auto step = [&](const int s32, const f32x4 a, const f32x4 b, const float rstd) __attribute__((always_inline)) {
            const f32x4 wa = *(const LAS f32x4*)(wcp + 128 * s32), wb = *(const LAS f32x4*)(wcp + 128 * s32 + 16), sa = *(const LAS f32x4*)(shp + 128 * s32), sb = *(const LAS f32x4*)(shp + 128 * s32 + 16);
            const f32x4 ha = a * rstd * wa + sa, hb = b * rstd * wb + sb;
            u32x4 hi; hi.x = pk2(ha[0], ha[1]); hi.y = pk2(ha[2], ha[3]); hi.z = pk2(hb[0], hb[1]); hi.w = pk2(hb[2], hb[3]);
            *(u32x4*)(H + 32 * s32) = hi;
            u32x4 lo; lo.x = pk2(ha[0] - bflo(hi.x), ha[1] - bfhi(hi.x)); lo.y = pk2(ha[2] - bflo(hi.y), ha[3] - bfhi(hi.y)); lo.z = pk2(hb[0] - bflo(hi.z), hb[1] - bfhi(hi.z)); lo.w = pk2(hb[2] - bflo(hi.w), hb[3] - bfhi(hi.w));
            const bf16x8 fh = *(const LAS bf16x8*)(rwh + 64 * s32), fl = *(const LAS bf16x8*)(rwl + 64 * s32);
            const bf16x8 bh = __builtin_bit_cast(bf16x8, hi), bl = __builtin_bit_cast(bf16x8, lo);
            acc = mfma16(fh, bh, acc); acc = mfma16(fh, bl, acc); acc = mfma16(fl, bh, acc);
        };
        if (isctx) {
            float ss = 0.f;
#pragma unroll 16
            for (int s32 = 0; s32 < 32; ++s32) ss += sq8(*(const f32x4*)(X + 32 * s32), *(const f32x4*)(X + 32 * s32 + 4));
            ss = sum_16_32(ss);
            const float rstd = 1.f / sqrtf(ss * (1.f / D) + 1e-6f);
#pragma unroll 8
            for (int s32 = 0; s32 < 32; ++s32) step(s32, *(const f32x4*)(X + 32 * s32), *(const f32x4*)(X + 32 * s32 + 4), rstd);
        } else {
            u32x4 xr[32];
            asm volatile("" : "+v"(XB), "+v"(H));
#pragma unroll
            for (int s32 = 0; s32 < 32; ++s32) xr[s32] = *(const u32x4*)(XB + 32 * s32);
            float ss = 0.f;
#pragma unroll
            for (int s32 = 0; s32 < 32; ++s32) ss += sq8(unpack4((u32x2){xr[s32].x, xr[s32].y}), unpack4((u32x2){xr[s32].z, xr[s32].w}));
            ss = sum_16_32(ss);
            const float rstd = 1.f / sqrtf(ss * (1.f / D) + 1e-6f);
#pragma unroll
            for (int s32 = 0; s32 < 32; ++s32) asm volatile("" : "+v"(xr[s32]));
#pragma unroll
            for (int s32 = 0; s32 < 32; ++s32) { step(s32, unpack4((u32x2){xr[s32].x, xr[s32].y}), unpack4((u32x2){xr[s32].z, xr[s32].w}), rstd); if ((s32 & 3) == 3) __builtin_amdgcn_sched_barrier(0); }
        }
        float aff[4], sel[4];
#pragma unroll
        for (int r = 0; r < 4; ++r) { aff[r] = __builtin_amdgcn_rcpf(1.f + __expf(-acc[r])); sel[r] = aff[r] + p.router_bias[4 * g + r]; }
        const float lo_ab = fminf(sel[0], sel[1]), hi_ab = fmaxf(sel[0], sel[1]), lo_cd = fminf(sel[2], sel[3]), hi_cd = fmaxf(sel[2], sel[3]);
        const float gs = fmaxf(hi_ab, hi_cd) + fmaxf(fminf(hi_ab, hi_cd), fmaxf(lo_ab, lo_cd));
        const int gsi = __float_as_int(gs);
        const float g0 = __int_as_float(__builtin_amdgcn_ds_bpermute(il << 2, gsi)), g1 = __int_as_float(__builtin_amdgcn_ds_bpermute((16 + il) << 2, gsi)),
                    g2 = __int_as_float(__builtin_amdgcn_ds_bpermute((32 + il) << 2, gsi)), g3 = __int_as_float(__builtin_amdgcn_ds_bpermute((48 + il) << 2, gsi));
        int best = 0; float bv = g0;
        if (g1 > bv) { bv = g1; best = 1; }
        if (g2 > bv) { bv = g2; best = 2; }
        if (g3 > bv) { bv = g3; best = 3; }
        if (g == best) {
            int i0 = 0; float v0 = sel[0], w0 = aff[0];
#pragma unroll
            for (int k = 1; k < 4; ++k) if (sel[k] > v0) { v0 = sel[k]; w0 = aff[k]; i0 = k; }
            int i1 = -1; float v1 = -1e30f, w1 = 0.f;
#pragma unroll
            for (int k = 0; k < 4; ++k) if (k != i0 && (i1 < 0 || sel[k] > v1)) { v1 = sel[k]; w1 = aff[k]; i1 = k; }
            const float wsum = w0 + w1;
            se0 = 4 * g + i0; se1 = 4 * g + i1; sw0 = w0 / wsum; sw1 = w1 / wsum; stok = t;
            q0 = __hip_atomic_fetch_add((LAS int*)(lds + O_CNT) + se0, 1, __ATOMIC_RELAXED, __HIP_MEMORY_SCOPE_WORKGROUP);
            q1 = __hip_atomic_fetch_add((LAS int*)(lds + O_CNT) + se1, 1, __ATOMIC_RELAXED, __HIP_MEMORY_SCOPE_WORKGROUP);
        }
    }
    LAS int* lcnt = (LAS int*)(lds + O_CNT); LAS int* lbase = lcnt + 16;
    __syncthreads();
    if (tid < 16) lbase[tid] = atomicAdd(&CNT[tid * 64], lcnt[tid]);
    __syncthreads();
    if (stok >= 0) {
        const int p0 = lbase[se0] + q0, p1 = lbase[se1] + q1;
        LIST[(size_t)se0 * T + p0] = 2 * stok; GW[2 * stok] = sw0;
        LIST[(size_t)se1 * T + p1] = 2 * stok + 1; GW[2 * stok + 1] = sw1;
    }
}

constexpr int MOE_BM = 144, MOE_PF = 3;
DI void moe_item(const Params& p, lptr lds, int l, int e, int r0, int nr) {
    typedef GemmTile<MOE_BM, 256, 1, 8, false, MOE_PF> G1; typedef GemmTile<MOE_BM, 256, 1, 8, true, 4> G2;
    const int tid = otid(), lane = tid & 63, wave = tid >> 6, wn = wave, il = lane & 15, g = lane >> 4;
    unsigned char* ws = p.ws;
    LAS int* rowent = (LAS int*)lds; LAS float* roww = (LAS float*)(lds + 1024);
    lptr stage = lds + 2048; lptr HE = lds + 2048 + (MOE_BM * 128 + 256 * 128);
    const int* LIST = (const int*)(ws + WS_LIST) + (size_t)e * T; const float* GW = (const float*)(ws + WS_GW);
    __syncthreads();
    if (tid < MOE_BM) { const int ent = tid < nr ? LIST[r0 + tid] : -1; rowent[tid] = ent; roww[tid] = ent >= 0 ? GW[ent] : 0.f; }
    __syncthreads();
    const bf16_t* H2 = (const bf16_t*)(ws + WS_H2);
    const bf16_t* arow[3];
#pragma unroll
    for (int q = 0; q < 3; ++q) { const int rr = (tid >> 3) + 64 * q; const int ent = rr < MOE_BM ? rowent[rr] : -1; const int tok = ent >= 0 ? (ent >> 1) : 0; arow[q] = H2 + (size_t)tok * D + (tid & 7) * 8; }
    const bf16_t* WGU = (const bf16_t*)(ws + WS_WGU) + ((size_t)l * 16 + e) * 512 * 1024;
    const bf16_t* WDN = (const bf16_t*)(ws + WS_WDN) + ((size_t)l * 16 + e) * 1024 * 256;
    f32x4 acc[9][2]; zero_acc(acc);
    G1::run_panels(acc, stage, arow, stage, WGU, 1024, 1024, 2, (size_t)256 * 1024, [&](const int nt2, f32x4 (&a_)[9][2]) __attribute__((always_inline)) {
        const int chn = 128 * nt2 + 16 * wn + 4 * g;
        const int panel = chn >> 6, cc = chn & 63;
#pragma unroll
        for (int mi = 0; mi < 9; ++mi) {
            const int r = 16 * mi + il;
            const f32x4 a = a_[mi][0], b = a_[mi][1];
            f32x4 o;
#pragma unroll
            for (int j = 0; j < 4; ++j) o[j] = fsilu(a[j]) * b[j];
            *(LAS u32x2*)(HE + panel * (MOE_BM * 128) + swz_off(r, cc >> 3) + (cc & 4) * 2) = pack4(o);
        }
    });
    __syncthreads();
    bf16_t* Y = (bf16_t*)(ws + WS_Y);
    const bf16_t* dummy[3] = {nullptr, nullptr, nullptr};
    G2::run_panels(acc, stage, dummy, HE, WDN, 256, 256, 4, (size_t)256 * 256, [&](const int nt, f32x4 (&a_)[9][2]) __attribute__((always_inline)) {
#pragma unroll
        for (int mi = 0; mi < 9; ++mi) {
            const int r = 16 * mi + il; const int ent = rowent[r]; const float w = roww[r];
            if (ent >= 0) {
#pragma unroll
                for (int ni = 0; ni < 2; ++ni) *(u32x2*)(Y + (size_t)ent * D + nt * 256 + wn * 32 + 16 * ni + 4 * g) = pack4(a_[mi][ni] * w);
            }
        }
    });
}
DI void phase_moe(const Params& p, lptr lds, int l) {
    int* CNT = (int*)(p.ws + WS_CNT) + l * 1024;
    LAS int* lc = (LAS int*)(lds + 256);
    __syncthreads();
    if (otid() < 16) lc[otid()] = __hip_atomic_fetch_add(&CNT[otid() * 64], 0, __ATOMIC_RELAXED, __HIP_MEMORY_SCOPE_AGENT);
    __syncthreads();
    int cnt[16], total = 0;
#pragma unroll
    for (int e = 0; e < 16; ++e) { cnt[e] = __builtin_amdgcn_readfirstlane(lc[e]); total += (cnt[e] + MOE_BM - 1) / MOE_BM; }
    __syncthreads();
    const int b_ = obid(), G_ = gridDim.x;
    for (int it = (G_ == 256) ? ((b_ & 7) * 32 + (b_ >> 3)) : b_; it < total; it += G_) {
        int base = 0, fe = 0, fm = 0, fc = 0, fn = 1;
#pragma unroll
        for (int e = 0; e < 16; ++e) { const int n = (cnt[e] + MOE_BM - 1) / MOE_BM; if (it >= base && it < base + n) { fe = e; fm = it - base; fc = cnt[e]; fn = n; } base += n; }
        const int rpi = (fc + fn - 1) / fn;
        const int r0 = fm * rpi; const int nr = (fc - r0 < rpi) ? (fc - r0) : rpi;
        moe_item(p, lds, l, fe, r0, nr);
    }
}

DI void phase_final(const Params& p) {
    const int tid_ = otid(); const int lane = tid_ & 63, wave = tid_ >> 6;
    const int gw = obid() * NWAVES + wave, NGW = gridDim.x * NWAVES;
    const float* g2 = modp(p, DEPTH - 1, 0, 5);
    struct Raw { u32x2 xb[4], ya[4], yb[4]; };
    auto load_raw = [&](const int t, Raw& r) __attribute__((always_inline)) {
        const bf16_t* XB = xbp(p) + (size_t)(t - CTX) * D; const bf16_t* Y0 = (const bf16_t*)(p.ws + WS_Y) + (size_t)(2 * t) * D;
#pragma unroll
        for (int j = 0; j < 4; ++j) { const int o = 4 * lane + 256 * j; r.xb[j] = *(const u32x2*)(XB + o); r.ya[j] = *(const u32x2*)(Y0 + o); r.yb[j] = *(const u32x2*)(Y0 + D + o); }
    };
    auto process = [&](const int t, Raw& r) __attribute__((always_inline)) {
        float* X = p.out + (size_t)(t - CTX) * D;
        f32x4 xv[4]; float ss = 0.f;
#pragma unroll
        for (int j = 0; j < 4; ++j) {
            const int o = 4 * lane + 256 * j;
            f32x4 xx = unpack4(r.xb[j]);
            const u32x2 a = r.ya[j], b = r.yb[j];
            const f32x4 g = *(const f32x4*)(g2 + o);
            xx[0] += g[0] * (bflo(a.x) + bflo(b.x)); xx[1] += g[1] * (bfhi(a.x) + bfhi(b.x));
            xx[2] += g[2] * (bflo(a.y) + bflo(b.y)); xx[3] += g[3] * (bfhi(a.y) + bfhi(b.y));
            xv[j] = xx; ss += (xx[0] * xx[0] + xx[1] * xx[1]) + (xx[2] * xx[2] + xx[3] * xx[3]);
        }
        const float rstd = 1.f / sqrtf(wave_sum(ss) * (1.f / D) + 1e-6f);
#pragma unroll
        for (int j = 0; j < 4; ++j) {
            const int o = 4 * lane + 256 * j; const f32x4 w = *(const f32x4*)(p.final_w + o);
            *(f32x4*)(X + o) = xv[j] * rstd * w;
        }
    };
#pragma unroll 1
    for (int t = CTX + gw; t < T; t += 2 * NGW) {
        Raw r0, r1; const int t1 = t + NGW; const bool has1 = t1 < T;
        load_raw(t, r0); if (has1) load_raw(t1, r1);
        process(t, r0); if (has1) process(t1, r1);
    }
}


#define XB_TMO      128
#define XB_XCNT(j)  (256  + 64 * (j))
#define XB_XSUB(j)  (1280 + 64 * (j))
#define XB_XGEN(j)  (2304 + 64 * (j))
#define XB_TOP      3328
#define XB_TOPGEN   3392
#define XCD_BAR_WORDS 3456
#define XB_SPIN_CAP (1u << 20)
DI unsigned xb_ld(unsigned* p)              { return __hip_atomic_load(p, __ATOMIC_RELAXED, __HIP_MEMORY_SCOPE_AGENT); }
DI unsigned xb_add(unsigned* p, unsigned v) { return __hip_atomic_fetch_add(p, v, __ATOMIC_RELAXED, __HIP_MEMORY_SCOPE_AGENT); }
DI unsigned xb_xcc_id() { return (unsigned)__builtin_amdgcn_s_getreg((3 << 11) | 20) & 0xFu; }
#define XB_SPIN(cond, bar) do { unsigned _sp = 0; while (cond) { __builtin_amdgcn_s_sleep(1); \
    if ((++_sp & 255u) == 0u) { if (xb_ld(&(bar)[XB_TMO])) break; if (_sp > XB_SPIN_CAP) { atomicAdd(&(bar)[XB_TMO], 1u); break; } } } } while (0)
struct XcdBarrier { unsigned* bar; unsigned x; volatile LAS unsigned* st; };
DI XcdBarrier xcd_barrier_post(unsigned* bar, volatile LAS unsigned* st) {
    XcdBarrier b; b.bar = bar; b.x = xb_xcc_id(); b.st = st;
    if (threadIdx.x == 0) (void)xb_add(&bar[XB_XCNT(b.x)], 1u);
    return b;
}
DI void xcd_barrier_complete(unsigned* bar, unsigned x, unsigned& nloc, unsigned& nx) {
    const unsigned G = gridDim.x * gridDim.y * gridDim.z;
    unsigned sum, cnt, mine, sp = 0u;
    for (;;) {
        sum = 0u; cnt = 0u; mine = 0u;
#pragma unroll
        for (unsigned j = 0; j < 16; ++j) { const unsigned c = xb_ld(&bar[XB_XCNT(j)]); sum += c; cnt += (c > 0u) ? 1u : 0u; mine = (j == x) ? c : mine; }
        if (sum == G) break;
        __builtin_amdgcn_s_sleep(1);
        if ((++sp & 255u) == 0u) { if (xb_ld(&bar[XB_TMO])) break; if (sp > XB_SPIN_CAP) { atomicAdd(&bar[XB_TMO], 1u); break; } }
    }
    nloc = mine > 0u ? mine : 1u; nx = cnt > 0u ? cnt : 1u;
}
DI void xcd_barrier(const XcdBarrier& b) {
    asm volatile("s_waitcnt vmcnt(0)" ::: "memory");
    __syncthreads();
    if (threadIdx.x == 0) {
        unsigned* bar = b.bar;
        __builtin_amdgcn_s_waitcnt(0);
        unsigned nloc = b.st[0], nx = b.st[1];
        if (nloc == 0u) { xcd_barrier_complete(bar, b.x, nloc, nx); b.st[0] = nloc; b.st[1] = nx; }
        const unsigned old = xb_add(&bar[XB_XSUB(b.x)], 1u);
        const unsigned gen = old / nloc;
        if (old + 1u == (gen + 1u) * nloc) {
            __builtin_amdgcn_fence(__ATOMIC_RELEASE, "agent");
            asm volatile("s_waitcnt vmcnt(0)" ::: "memory");
            const unsigned og = xb_add(&bar[XB_TOP], 1u);
            const unsigned tg = og / nx;
            if (og + 1u == (tg + 1u) * nx) xb_add(&bar[XB_TOPGEN], 1u);
            else XB_SPIN(xb_ld(&bar[XB_TOPGEN]) == tg, bar);
            __builtin_amdgcn_fence(__ATOMIC_ACQUIRE, "agent");
            xb_add(&bar[XB_XGEN(b.x)], 1u);
            asm volatile("s_waitcnt vmcnt(0)" ::: "memory");
        } else {
            XB_SPIN(xb_ld(&bar[XB_XGEN(b.x)]) == gen, bar);
            __builtin_amdgcn_fence(__ATOMIC_ACQUIRE, "agent");
            asm volatile("s_waitcnt vmcnt(0)" ::: "memory");
        }
    }
    __syncthreads();
}


constexpr int NPHASE = 2 + 8 * DEPTH + 1;
DI void run_phase(const Params& p, lptr lds, int ph) {
#ifdef PHASE_ONLY
    ph = PHASE_ONLY;
#endif
    if (ph == 0) { phase_p0(p, lds); return; }
    if (ph == 1) { phase_p0b(p); return; }
    if (ph == NPHASE - 1) { phase_final(p); return; }
    const int l = (ph - 2) >> 3, s = (ph - 2) & 7;
    switch (s) {
        case 0: phase_prep(p, l); break;
        case 1: phase_inproj(p, lds, l); break;
        case 2: phase_pc(p, lds, l); break;
        case 3: phase_pd(p, lds); break;
        case 4: phase_pe(p, lds); break;
        case 5: phase_outproj(p, lds, l); break;
        case 6: phase_router(p, lds, l); break;
        default: phase_moe(p, lds, l); break;
    }
}

__global__ void __launch_bounds__(NTHREADS) fwd_kernel(Params p) {
    extern __shared__ __attribute__((aligned(16))) unsigned char smem[];
    lptr lds = (lptr)smem;
    volatile LAS unsigned* st = (volatile LAS unsigned*)(lds + LDS_BYTES - 16);
    if (threadIdx.x < 4) st[threadIdx.x] = 0u;
    __syncthreads();
    const XcdBarrier bar = xcd_barrier_post((unsigned*)(p.ws + WS_BAR), st);
    for (int ph = p.ph_lo; ph < p.ph_hi; ++ph) {
        run_phase(p, lds, ph);
        if (ph + 1 < p.ph_hi) {
#if MK_CGSYNC
            asm volatile("s_waitcnt vmcnt(0) lgkmcnt(0)" ::: "memory");
            cg::this_grid().sync();
            __builtin_amdgcn_fence(__ATOMIC_ACQUIRE, "agent");
            asm volatile("s_waitcnt vmcnt(0)" ::: "memory");
#else
            xcd_barrier(bar);
#endif
        }
    }
}

extern "C" void kernel_launch(void* const* d_in, const int* in_sizes, int n_in, void* d_out, int out_size, void* d_ws, size_t ws_size, hipStream_t stream) {
    static int grid = 0;
    if (grid == 0) {
        int dev = 0, cus = 0, per_cu = 0;
        hipGetDevice(&dev);
        hipDeviceGetAttribute(&cus, hipDeviceAttributeMultiprocessorCount, dev);
        hipFuncSetAttribute((const void*)fwd_kernel, hipFuncAttributeMaxDynamicSharedMemorySize, LDS_BYTES);
        hipOccupancyMaxActiveBlocksPerMultiprocessor(&per_cu, (const void*)fwd_kernel, NTHREADS, LDS_BYTES);
        if (per_cu < 1) { fprintf(stderr, "kernel_launch: occupancy query says %d blocks/CU\n", per_cu); per_cu = 1; }
        (void)hipGetLastError();
        grid = cus > 0 ? cus : 256;
        if (ws_size < WS_END) fprintf(stderr, "kernel_launch: workspace too small: %zu < %zu\n", ws_size, (size_t)WS_END);
    }
    hipMemsetAsync((char*)d_ws, 0, WS_CTL_BYTES, stream);
    Params p{};
    const float** pp = (const float**)&p;
    for (int i = 0; i < 24; ++i) pp[i] = (const float*)d_in[i];
    p.out = (float*)d_out; p.ws = (unsigned char*)d_ws; p.pad = 0;
#if MK_MULTI
    p.coop = 0;
    for (int ph = 0; ph < NPHASE; ++ph) {
        p.ph_lo = ph; p.ph_hi = ph + 1;
        hipLaunchKernelGGL(fwd_kernel, dim3(grid), dim3(NTHREADS), LDS_BYTES, stream, p);
    }
#elif defined(MK_CUTS)
    {
        const int cuts[] = {0, MK_CUTS, NPHASE};
        const int nc = (int)(sizeof(cuts) / sizeof(int));
        p.coop = 1;
        for (int i = 0; i + 1 < nc; ++i) {
            p.ph_lo = cuts[i]; p.ph_hi = cuts[i + 1];
            if (i > 0) hipMemsetAsync((char*)d_ws + WS_BAR, 0, WS_CTL_BYTES - WS_BAR, stream);
            hipLaunchKernelGGL(fwd_kernel, dim3(grid), dim3(NTHREADS), LDS_BYTES, stream, p);
        }
    }
#else
    p.coop = 1; p.ph_lo = 0; p.ph_hi = NPHASE;
    void* args[] = {&p};
    hipError_t e = hipLaunchCooperativeKernel((const void*)fwd_kernel, dim3(grid), dim3(NTHREADS), args, LDS_BYTES, stream);
    if (e != hipSuccess) fprintf(stderr, "cooperative launch failed: %s (grid %d)\n", hipGetErrorString(e), grid);
#endif
}
```

```cpp
#include <hip/hip_runtime.h>
#include <hip/hip_cooperative_groups.h>
#include <cstdio>
#include <cstdint>
namespace cg = cooperative_groups;

#ifndef MK_FP8
#define MK_FP8 1
#endif
#ifndef MK_CGSYNC
#define MK_CGSYNC 0
#endif
#ifndef MK_MULTI
#define MK_MULTI 0
#endif

#define DI __device__ __forceinline__
#define LAS __attribute__((address_space(3)))
typedef unsigned short bf16_t;
typedef short bf16x8 __attribute__((ext_vector_type(8)));
typedef short s16x4 __attribute__((ext_vector_type(4)));
typedef float f32x4 __attribute__((ext_vector_type(4)));
typedef float f32x16 __attribute__((ext_vector_type(16)));
typedef unsigned u32x4 __attribute__((ext_vector_type(4)));
typedef unsigned u32x2 __attribute__((ext_vector_type(2)));
typedef LAS unsigned char* lptr;

constexpr int D = 1024, SEQ = 16384, CTX = 256, T = SEQ + CTX, DEPTH = 2;
constexpr int NIN = 2400, NINP = 2560;
constexpr int NCH = T / 128;
constexpr int NTHREADS = 512, NWAVES = 8;
constexpr int LDS_BYTES = 147456;
constexpr float QSCALE = 0.10206207261596577f * 1.4426950408889634f;

constexpr size_t WS_CNT  = 0;
constexpr size_t WS_BAR  = 16384;
constexpr size_t WS_CTL_BYTES = 32768;
constexpr size_t WS_TAB  = 32768;
constexpr int    MOD_KS  = 64;
constexpr size_t WS_MODP = WS_TAB + 256 * 16 * 4;
constexpr size_t WS_MOD  = WS_MODP + (size_t)2 * MOD_KS * 2 * 6144 * 4;
constexpr size_t WS_XC   = WS_MOD + (size_t)2 * 2 * 6144 * 4;
constexpr size_t WS_GW   = WS_XC + (size_t)CTX * D * 4;
constexpr size_t WS_LIST = WS_GW + (size_t)T * 2 * 4;
constexpr size_t WS_WIN  = WS_LIST + (size_t)16 * T * 4;
constexpr size_t WS_WOUT = WS_WIN + (size_t)2 * NINP * D * 2;
constexpr size_t WS_WUQ  = WS_WOUT + (size_t)2 * D * D * 2;
constexpr size_t WS_WUKV = WS_WUQ + (size_t)2 * 640 * 192 * 2;
constexpr size_t WS_WGU  = WS_WUKV + (size_t)2 * 768 * 128 * 2;
constexpr size_t WS_WDN  = WS_WGU + (size_t)2 * 16 * 512 * 1024 * 2;
constexpr size_t WS_HA   = WS_WDN + (size_t)2 * 16 * 1024 * 256 * 2;
constexpr size_t SZ_HA   = (size_t)T * D * 2;
constexpr size_t WS_XB   = WS_HA;
constexpr size_t WS_M    = WS_HA + SZ_HA;
constexpr size_t WS_U    = WS_M;
constexpr size_t WS_RQ   = WS_U + (size_t)T * 256 * 2;
constexpr size_t WS_RK   = WS_RQ + (size_t)T * 192 * 2;
constexpr size_t WS_RV   = WS_RK + (size_t)T * 192 * 2;
constexpr size_t WS_GF   = WS_RV + (size_t)T * 384 * 2;
constexpr size_t WS_GB   = WS_GF + (size_t)T * 384 * 2;
constexpr size_t WS_CQ   = WS_GB + (size_t)T * 384 * 2;
constexpr size_t WS_CKV  = WS_CQ + (size_t)T * 192 * 2;
constexpr size_t WS_KR   = WS_CKV + (size_t)T * 128 * 2;
constexpr size_t WS_DS   = WS_KR + (size_t)T * 32 * 2;
constexpr size_t WS_SST  = WS_DS + (size_t)2 * NCH * 6 * 2048 * 4;
constexpr size_t WS_KB   = WS_SST + (size_t)2 * NCH * 6 * 2048 * 4;
constexpr size_t WS_QB   = WS_KB + (size_t)6 * T * 96 * 2;
constexpr size_t WS_VT   = WS_QB + (size_t)6 * T * 96 * 2;
constexpr size_t WS_END  = WS_VT + (size_t)6 * 64 * T * 2;
constexpr size_t WS_PART = WS_END;
constexpr size_t WS_PST  = WS_PART + (size_t)2 * 128 * 256 * 64 * 2;
constexpr size_t WS_END2 = WS_PST + (size_t)2 * 128 * 256 * 2 * 4;
static_assert(WS_END2 <= (size_t)268435456, "workspace map exceeds 256 MiB");
constexpr size_t WS_H2   = WS_KB;
static_assert(WS_H2 + (size_t)T * D * 2 <= WS_VT, "H2 overlay must fit in KB|QB");
constexpr size_t WS_Y    = WS_M;
static_assert(WS_Y + (size_t)T * 2 * D * 2 <= WS_END, "Y overlay");
static_assert(WS_END <= (size_t)268435456, "workspace map exceeds 256 MiB");

struct Params {
    const float *x, *c, *ctx, *c_ctx, *ada_w, *ada_b, *norm1_w, *norm2_w, *w_in, *conv_dw, *conv_b, *conv_ln_w, *conv_ln_b,
                *q_norm_w, *w_uq, *kv_norm_w, *w_ukv, *w_out, *router_w, *router_bias, *moe_g, *moe_u, *moe_d, *final_w;
    float* out; unsigned char* ws; int ph_lo, ph_hi, coop, pad;
};

DI int otid() { int t = threadIdx.x; asm volatile("" : "+v"(t)); return t; }
DI int obid() { int b = blockIdx.x; asm volatile("" : "+s"(b)); return b; }
DI unsigned f2bf(float f) { unsigned u = __float_as_uint(f); return (u + 0x7fffu + ((u >> 16) & 1u)) >> 16; }
typedef float f32x2_t __attribute__((ext_vector_type(2)));
typedef __bf16 bf16x2_t __attribute__((ext_vector_type(2)));
DI unsigned pk2(float lo, float hi) { f32x2_t v = {lo, hi}; bf16x2_t b = __builtin_convertvector(v, bf16x2_t); return __builtin_bit_cast(unsigned, b); }
DI float bf2f(unsigned short h) { return __uint_as_float(((unsigned)h) << 16); }
DI float bflo(unsigned u) { return __uint_as_float(u << 16); }
DI float bfhi(unsigned u) { return __uint_as_float(u & 0xffff0000u); }
DI float fsilu(float x) { return x / (1.f + __expf(-x)); }
DI float fsigm(float x) { return 1.f / (1.f + __expf(-x)); }
DI float xshfl(float v, int m) { return __int_as_float(__builtin_amdgcn_ds_bpermute((((int)otid() & 63) ^ m) << 2, __float_as_int(v))); }
DI float add_x32(float v) { return v + xshfl(v, 32); }
DI float sum_16_32(float v) { v += xshfl(v, 16); return v + xshfl(v, 32); }
DI float wave_sum(float v) {
#pragma unroll
    for (int o = 1; o < 64; o <<= 1) v += xshfl(v, o);
    return v;
}
DI f32x4 zacc4() { f32x4 z = {0.f, 0.f, 0.f, 0.f}; asm volatile("" : "+v"(z)); return z; }
DI f32x4 mfma16(bf16x8 a, bf16x8 b, f32x4 c) { return __builtin_amdgcn_mfma_f32_16x16x32_bf16(a, b, c, 0, 0, 0); }
DI f32x16 mfma32(bf16x8 a, bf16x8 b, f32x16 c) { return __builtin_amdgcn_mfma_f32_32x32x16_bf16(a, b, c, 0, 0, 0); }
DI u32x2 pack4(f32x4 v) { u32x2 r; r.x = pk2(v[0], v[1]); r.y = pk2(v[2], v[3]); return r; }
typedef int i32x8 __attribute__((ext_vector_type(8)));
DI unsigned pk4_fp8(f32x4 v) { int r = 0; r = __builtin_amdgcn_cvt_pk_fp8_f32(v[0], v[1], r, false); r = __builtin_amdgcn_cvt_pk_fp8_f32(v[2], v[3], r, true); return (unsigned)r; }
DI f32x16 mfma_mx(i32x8 a, i32x8 b, f32x16 c) { return __builtin_amdgcn_mfma_scale_f32_32x32x64_f8f6f4(a, b, c, 0, 0, 0, 0x7f7f7f7f, 0, 0x7f7f7f7f); }
DI float gamma_f(int h) { return 1.f - exp2f(-5.f - (float)h); }

DI int rope_perm32(int d) { const int pb = (d >> 3) & 1; const int i = (d & 7) + ((d >> 4) << 3); return pb * 16 + i; }
DI int map_row(int MODE, int n) {
    if (MODE == 1) {
        if (n < 512) { const int ch = n & 255, gate = n >> 8; return ((ch >> 4) << 5) + (gate << 4) + (ch & 15); }
        if (n < 896) { const int o = n - 512; return 512 + (o & ~31) + rope_perm32(o & 31); }
        if (n < 2368) return n;
        return 2368 + rope_perm32(n - 2368);
    } else if (MODE == 2) {
        const int h = n / 96, d = n % 96; return h * 96 + (d < 64 ? d : 64 + rope_perm32(d - 64));
    } else if (MODE == 3) {
        return ((n >> 4) << 5) + (n & 15);
    } else if (MODE == 4) {
        return ((n >> 4) << 5) + 16 + (n & 15);
    }
    return n;
}

DI void transpose_item(int MODE, const float* W, int K, int N, bf16_t* WT, const float* kscale, LAS unsigned* scr, int item, int lane) {
    const int nblk = (N + 63) >> 6, kb = item / nblk, nb = item - kb * nblk, k0 = 64 * kb, n0 = 64 * nb;
    const int c4 = lane & 15, g = lane >> 4;
    const int ncol = n0 + 4 * c4;
    const float* src = W + (size_t)(k0 + 2 * g) * N + (ncol < N ? ncol : 0);
    f32x4 va[8], vb[8];
#pragma unroll
    for (int i = 0; i < 8; ++i) { va[i] = __builtin_nontemporal_load((const f32x4*)(src + (size_t)(8 * i) * N)); vb[i] = __builtin_nontemporal_load((const f32x4*)(src + (size_t)(8 * i + 1) * N)); }
    if (kscale) {
#pragma unroll
        for (int i = 0; i < 8; ++i) {
            const float sa = kscale[k0 + 8 * i + 2 * g], sb = kscale[k0 + 8 * i + 2 * g + 1];
#pragma unroll
            for (int j = 0; j < 4; ++j) { va[i][j] *= sa; vb[i][j] *= sb; }
        }
    }
#pragma unroll
    for (int i = 0; i < 8; ++i)
#pragma unroll
        for (int j = 0; j < 4; ++j) scr[(4 * c4 + j) * 33 + 4 * i + g] = pk2(va[i][j], vb[i][j]);
    asm volatile("s_waitcnt lgkmcnt(0)" ::: "memory");
    const int c = lane & 7;
    const int nlim = N - n0;
#pragma unroll
    for (int jj = 0; jj < 8; ++jj) {
        const int n = (lane >> 3) + 8 * jj; const LAS unsigned* q = scr + n * 33 + 4 * c;
        u32x4 o; o.x = q[0]; o.y = q[1]; o.z = q[2]; o.w = q[3];
        if (n < nlim) *(u32x4*)(WT + (size_t)map_row(MODE, n0 + n) * K + k0 + 8 * c) = o;
    }
    asm volatile("s_waitcnt lgkmcnt(0)" ::: "memory");
}

constexpr int I_IN = 16 * 38, I_OUT = 16 * 16, I_UQ = 3 * 9, I_UKV = 2 * 12, I_G = 16 * 64, I_U = 16 * 64, I_D = 16 * 64, I_ADA = MOD_KS * 24;
constexpr int I_SMALL = I_IN + I_OUT + I_UQ + I_UKV, I_MOE = I_G + I_U + I_D, I_L = I_SMALL + I_MOE + I_ADA;
DI void weight_item(const Params& p, LAS unsigned* scr, int l, int r, int lane) {
    unsigned char* ws = p.ws;
    int mode = 0, K = D, N = D; const float* W; bf16_t* WT; const float* ksc = nullptr;
    if (r < I_IN) { mode = 1; N = NIN; W = p.w_in + (size_t)l * D * NIN; WT = (bf16_t*)(ws + WS_WIN) + (size_t)l * NINP * D; }
    else if ((r -= I_IN) < I_OUT) { W = p.w_out + (size_t)l * D * D; WT = (bf16_t*)(ws + WS_WOUT) + (size_t)l * D * D; }
    else if ((r -= I_OUT) < I_UQ) { mode = 2; K = 192; N = 576; W = p.w_uq + (size_t)l * 192 * 576; WT = (bf16_t*)(ws + WS_WUQ) + (size_t)l * 640 * 192; ksc = p.q_norm_w + l * 192; }
    else if ((r -= I_UQ) < I_UKV) { K = 128; N = 768; W = p.w_ukv + (size_t)l * 128 * 768; WT = (bf16_t*)(ws + WS_WUKV) + (size_t)l * 768 * 128; ksc = p.kv_norm_w + l * 128; }
    else if ((r -= I_UKV) < I_G) { const int e = r / 64; r %= 64; mode = 3; N = 256; W = p.moe_g + ((size_t)l * 16 + e) * 1024 * 256; WT = (bf16_t*)(ws + WS_WGU) + ((size_t)l * 16 + e) * 512 * 1024; }
    else if ((r -= I_G) < I_U) { const int e = r / 64; r %= 64; mode = 4; N = 256; W = p.moe_u + ((size_t)l * 16 + e) * 1024 * 256; WT = (bf16_t*)(ws + WS_WGU) + ((size_t)l * 16 + e) * 512 * 1024; }
    else { r -= I_U; const int e = r / 64; r %= 64; K = 256; N = 1024; W = p.moe_d + ((size_t)l * 16 + e) * 256 * 1024; WT = (bf16_t*)(ws + WS_WDN) + ((size_t)l * 16 + e) * 1024 * 256; }
    transpose_item(mode, W, K, N, WT, ksc, scr, r, lane);
}
DI bool defer_moe_weights() { return DEPTH > 1 && (int)gridDim.x * 5 >= T / 16; }
constexpr int INPROJ_TILES = (T / 256) * (NINP / 256);
DI bool defer_moe_weights0() { return (int)gridDim.x == 256; }
DI int inproj_first_idle() { return INPROJ_TILES - (INPROJ_TILES / 256) * 256; }

DI void phase_p0(const Params& p, lptr lds) {
    const int tid = otid(), lane = tid & 63, wave = __builtin_amdgcn_readfirstlane(tid >> 6);
    const int gw = obid() * NWAVES + wave, NGW = gridDim.x * NWAVES;
    unsigned char* ws = p.ws;
    LAS unsigned* scr = (LAS unsigned*)(lds + wave * 8448);
    static_assert(DEPTH == 2, "item list below is written for two layers");
    const bool defer0 = defer_moe_weights0(), defer1 = defer_moe_weights();
    const int n0 = defer0 ? I_L - I_MOE : I_L, n1 = defer1 ? I_L - I_MOE : I_L;
#pragma unroll 1
    for (int it = gw; it < n0 + n1; it += NGW) {
        const int l = it < n0 ? 0 : 1; int r = it - (l ? n0 : 0);
        if ((l ? defer1 : defer0) && r >= I_SMALL) r += I_MOE;
        if (r < I_L - I_ADA) { weight_item(p, scr, l, r, lane); continue; }
        r -= I_L - I_ADA;
        {
            const int ks = r / 24, cb = r % 24, n = cb * 256 + 4 * lane;
            const float* W = p.ada_w + (size_t)l * D * 6144 + (size_t)(ks * 16) * 6144 + n;
            f32x4 wv[16];
#pragma unroll
            for (int k = 0; k < 16; ++k) wv[k] = __builtin_nontemporal_load((const f32x4*)(W + (size_t)k * 6144));
            f32x4 aL = {0.f, 0.f, 0.f, 0.f}, aC = aL;
#pragma unroll
            for (int k = 0; k < 16; ++k) {
                const float cl = p.c[ks * 16 + k], cc = p.c_ctx[ks * 16 + k];
                const float sl = fsilu(cl), sc = fsilu(cc);
#pragma unroll
                for (int j = 0; j < 4; ++j) { aL[j] += sl * wv[k][j]; aC[j] += sc * wv[k][j]; }
            }
            float* mp = (float*)(ws + WS_MODP) + ((size_t)(l * MOD_KS + ks) * 2) * 6144;
            *(f32x4*)(mp + n) = aL; *(f32x4*)(mp + 6144 + n) = aC;
        }
    }
    {
        const int gt = obid() * NTHREADS + tid, NGT = gridDim.x * NTHREADS;
        const u32x4 z = {0u, 0u, 0u, 0u};
        for (int i = gt; i < 2 * 160 * 128; i += NGT) { const int l = i / (160 * 128), r = i % (160 * 128); *(u32x4*)((bf16_t*)(ws + WS_WIN) + ((size_t)l * NINP + 2400) * D + r * 8) = z; }
        for (int i = gt; i < 2 * 64 * 24; i += NGT) { const int l = i / (64 * 24), r = i % (64 * 24); *(u32x4*)((bf16_t*)(ws + WS_WUQ) + ((size_t)l * 640 + 576) * 192 + r * 8) = z; }
        if (gt < 256 * 8) {
            const int pos = gt >> 3, f = gt & 7;
            const float inv = powf(10000.f, -(float)f / 8.f);
            const float ang = (float)pos * inv;
            float* tab = (float*)(ws + WS_TAB);
            tab[pos * 16 + f] = cosf(ang); tab[pos * 16 + 8 + f] = sinf(ang);
        }
    }
}

DI void phase_p0b(const Params& p) {
    const int gt = obid() * NTHREADS + otid(), NGT = gridDim.x * NTHREADS;
    for (int i = gt; i < 2 * 2 * 6144; i += NGT) {
        const int l = i / 12288, v = (i / 6144) & 1, n = i % 6144;
        float s = p.ada_b[l * 6144 + n];
        const float* mp = (const float*)(p.ws + WS_MODP);
#pragma unroll 16
        for (int ks = 0; ks < MOD_KS; ++ks) s += mp[((size_t)(l * MOD_KS + ks) * 2 + v) * 6144 + n];
        ((float*)(p.ws + WS_MOD))[i] = s;
    }
}
DI bf16_t* catp(const Params& p) { return (bf16_t*)p.out; }
DI bf16_t* xbp(const Params& p) { return (bf16_t*)(p.ws + WS_XB); }
DI f32x4 ld4bf(const bf16_t* q) { const u32x2 u = *(const u32x2*)q; return (f32x4){bflo(u.x), bfhi(u.x), bflo(u.y), bfhi(u.y)}; }
DI f32x4 unpack4(u32x2 u) { return (f32x4){bflo(u.x), bfhi(u.x), bflo(u.y), bfhi(u.y)}; }
DI const float* modp(const Params& p, int l, int v, int chunk) { return (const float*)(p.ws + WS_MOD) + ((size_t)(l * 2 + v) * 6144) + chunk * 1024; }

struct PrepRaw { f32x4 xf[4]; u32x2 xb[4], ya[4], yb[4]; };
DI void phase_prep(const Params& p, int l) {
    const int tid_ = otid(); const int lane = tid_ & 63, wave = tid_ >> 6;
    const int gw = obid() * NWAVES + wave, NGW = gridDim.x * NWAVES;
    auto load_raw = [&](const int t, PrepRaw& r) __attribute__((always_inline)) {
        const bool isctx = t < CTX;
        if (l == 0) {
            const float* src = isctx ? p.ctx + (size_t)t * D : p.x + (size_t)(t - CTX) * D;
#pragma unroll
            for (int j = 0; j < 4; ++j) r.xf[j] = *(const f32x4*)(src + 4 * lane + 256 * j);
        } else {
            const float* X = (const float*)(p.ws + WS_XC) + (size_t)(isctx ? t : 0) * D;
            const bf16_t* XB = xbp(p) + (size_t)(isctx ? 0 : t - CTX) * D;
            const bf16_t* Y0 = (const bf16_t*)(p.ws + WS_Y) + (size_t)(2 * t) * D;
#pragma unroll
            for (int j = 0; j < 4; ++j) {
                const int o = 4 * lane + 256 * j;
                if (isctx) r.xf[j] = *(const f32x4*)(X + o); else r.xb[j] = *(const u32x2*)(XB + o);
                r.ya[j] = *(const u32x2*)(Y0 + o); r.yb[j] = *(const u32x2*)(Y0 + D + o);
            }
        }
    };
    auto process = [&](const int t, PrepRaw& r) __attribute__((always_inline)) {
        const bool isctx = t < CTX; const int v = isctx ? 1 : 0;
        f32x4 xv[4];
        if (l == 0) {
#pragma unroll
            for (int j = 0; j < 4; ++j) xv[j] = r.xf[j];
        } else {
            float* X = (float*)(p.ws + WS_XC) + (size_t)(isctx ? t : 0) * D;
            bf16_t* XB = xbp(p) + (size_t)(isctx ? 0 : t - CTX) * D;
            const float* g2 = modp(p, l - 1, v, 5);
#pragma unroll
            for (int j = 0; j < 4; ++j) {
                const int o = 4 * lane + 256 * j;
                f32x4 xx = isctx ? r.xf[j] : unpack4(r.xb[j]);
                const u32x2 a = r.ya[j], b = r.yb[j];
                const f32x4 g = *(const f32x4*)(g2 + o);
                xx[0] += g[0] * (bflo(a.x) + bflo(b.x)); xx[1] += g[1] * (bfhi(a.x) + bfhi(b.x));
                xx[2] += g[2] * (bflo(a.y) + bflo(b.y)); xx[3] += g[3] * (bfhi(a.y) + bfhi(b.y));
                if (isctx) *(f32x4*)(X + o) = xx;
                else { const u32x2 pk = pack4(xx); *(u32x2*)(XB + o) = pk; xx = unpack4(pk); }
                xv[j] = xx;
            }
        }
        float ss = 0.f;
#pragma unroll
        for (int j = 0; j < 4; ++j) ss += (xv[j][0] * xv[j][0] + xv[j][1] * xv[j][1]) + (xv[j][2] * xv[j][2] + xv[j][3] * xv[j][3]);
        const float rstd = 1.f / sqrtf(wave_sum(ss) * (1.f / D) + 1e-6f);
        const float* nw = p.norm1_w + l * D; const float* sh = modp(p, l, v, 0); const float* sc = modp(p, l, v, 1);
        bf16_t* H = catp(p) + (size_t)t * D;
#pragma unroll
        for (int j = 0; j < 4; ++j) {
            const int o = 4 * lane + 256 * j;
            const f32x4 w = *(const f32x4*)(nw + o), s1 = *(const f32x4*)(sc + o), s0 = *(const f32x4*)(sh + o);
            f32x4 h;
#pragma unroll
            for (int i = 0; i < 4; ++i) h[i] = xv[j][i] * rstd * w[i] * (1.f + s1[i]) + s0[i];
            *(u32x2*)(H + o) = pack4(h);
        }
    };
#pragma unroll 1
    for (int t = gw; t < T; t += 2 * NGW) {
        PrepRaw r0, r1; const int t1 = t + NGW; const bool has1 = t1 < T;
        load_raw(t, r0); if (has1) load_raw(t1, r1);
        process(t, r0); if (has1) process(t1, r1);
    }
}

DI int swz_off(int row, int chunk) { return row * 128 + ((chunk ^ (row & 7)) << 4); }
template <int BM, int BN, int WM, int WN, bool A_LDS, int PF = 1>
struct GemmTile {
    static constexpr int MI = BM / WM / 16, NI = BN / WN / 16;
    static constexpr int AP = (BM + 63) / 64, BP = BN / 64;
    static constexpr int A_BYTES = A_LDS ? 0 : BM * 128, B_BYTES = BN * 128;
    DI static void run(f32x4 (&acc)[MI][NI], lptr stage, const bf16_t* const (&arow)[AP], lptr apanels, const bf16_t* Bt, int ldb, int K) { run(acc, stage, arow, apanels, Bt, ldb, K, [] {}); }
    template <class Pre>
    DI static void run(f32x4 (&acc)[MI][NI], lptr stage, const bf16_t* const (&arow)[AP], lptr apanels, const bf16_t* Bt, int ldb, int K, Pre&& pre) {
        const int tid = otid(), lane = tid & 63, wave = tid >> 6, wm = wave / WN, wn = wave % WN;
        const int lr = tid >> 3, lc = tid & 7;
        lptr As = stage; lptr Bs = stage + A_BYTES;
        const bf16_t* brow[BP];
#pragma unroll
        for (int q = 0; q < BP; ++q) brow[q] = Bt + (size_t)(lr + 64 * q) * ldb + lc * 8;
        u32x4 ra[PF][AP], rb[PF][BP];
        const int nk = K / 64;
#pragma unroll
        for (int s = 0; s < PF; ++s) if (s < nk) {
            if (!A_LDS) {
#pragma unroll
                for (int q = 0; q < AP; ++q) if (BM % 64 == 0 || lr + 64 * q < BM) ra[s][q] = *(const u32x4*)(arow[q] + s * 64);
            }
#pragma unroll
            for (int q = 0; q < BP; ++q) rb[s][q] = *(const u32x4*)(brow[q] + s * 64);
        }
        pre();
        for (int kt0 = 0; kt0 < nk; kt0 += PF) {
#pragma unroll
            for (int s = 0; s < PF; ++s) {
                const int kt = kt0 + s;
                if (PF > 1 && kt >= nk) break;
                __syncthreads();
                if (!A_LDS) {
#pragma unroll
                    for (int q = 0; q < AP; ++q) if (BM % 64 == 0 || lr + 64 * q < BM) *(LAS u32x4*)(As + swz_off(lr + 64 * q, lc)) = ra[s][q];
                }
#pragma unroll
                for (int q = 0; q < BP; ++q) *(LAS u32x4*)(Bs + swz_off(lr + 64 * q, lc)) = rb[s][q];
                __syncthreads();
                if (kt + PF < nk) {
                    if (!A_LDS) {
#pragma unroll
                        for (int q = 0; q < AP; ++q) if (BM % 64 == 0 || lr + 64 * q < BM) ra[s][q] = *(const u32x4*)(arow[q] + (kt + PF) * 64);
                    }
#pragma unroll
                    for (int q = 0; q < BP; ++q) rb[s][q] = *(const u32x4*)(brow[q] + (kt + PF) * 64);
                }
                lptr Ap = A_LDS ? apanels + kt * (BM * 128) : As;
#pragma unroll
                for (int ks = 0; ks < 2; ++ks) {
                    bf16x8 af[MI], bfr[NI];
                    const int ch = 4 * ks + (lane >> 4);
#pragma unroll
                    for (int mi = 0; mi < MI; ++mi) af[mi] = *(const LAS bf16x8*)(Ap + swz_off(wm * (BM / WM) + 16 * mi + (lane & 15), ch));
#pragma unroll
                    for (int ni = 0; ni < NI; ++ni) bfr[ni] = *(const LAS bf16x8*)(Bs + swz_off(wn * (BN / WN) + 16 * ni + (lane & 15), ch));
#pragma unroll
                    for (int mi = 0; mi < MI; ++mi)
#pragma unroll
                        for (int ni = 0; ni < NI; ++ni) acc[mi][ni] = mfma16(bfr[ni], af[mi], acc[mi][ni]);
                }
            }
        }
    }
    template <class Epi>
    DI static void run_panels(f32x4 (&acc)[MI][NI], lptr stage, const bf16_t* const (&arow)[AP], lptr apanels, const bf16_t* Bt, int ldb, int K, int NP, size_t bstride, Epi&& epi) {
        const int tid = otid(), lane = tid & 63, wave = tid >> 6, wm = wave / WN, wn = wave % WN;
        const int lr = tid >> 3, lc = tid & 7;
        lptr As = stage; lptr Bs = stage + A_BYTES;
        const bf16_t* brow[BP];
#pragma unroll
        for (int q = 0; q < BP; ++q) brow[q] = Bt + (size_t)(lr + 64 * q) * ldb + lc * 8;
        u32x4 ra[PF][AP], rb[PF][BP];
        const int nk = K / 64, ntot = nk * NP;
        int lkt = 0; size_t lpo = 0;
        auto fetch = [&](const int s) __attribute__((always_inline)) {
            if (!A_LDS) {
#pragma unroll
                for (int q = 0; q < AP; ++q) if (BM % 64 == 0 || lr + 64 * q < BM) ra[s][q] = *(const u32x4*)(arow[q] + lkt * 64);
            }
#pragma unroll
            for (int q = 0; q < BP; ++q) rb[s][q] = *(const u32x4*)(brow[q] + lpo + lkt * 64);
            if (++lkt == nk) { lkt = 0; lpo += bstride; }
        };
#pragma unroll
        for (int s = 0; s < PF; ++s) if (s < ntot) fetch(s);
        int kt = 0, pn = 0;
        for (int f0 = 0; f0 < ntot; f0 += PF) {
#pragma unroll
            for (int s = 0; s < PF; ++s) {
                const int f = f0 + s;
                if (f >= ntot) break;
                __syncthreads();
                if (!A_LDS) {
#pragma unroll
                    for (int q = 0; q < AP; ++q) if (BM % 64 == 0 || lr + 64 * q < BM) *(LAS u32x4*)(As + swz_off(lr + 64 * q, lc)) = ra[s][q];
                }
#pragma unroll
                for (int q = 0; q < BP; ++q) *(LAS u32x4*)(Bs + swz_off(lr + 64 * q, lc)) = rb[s][q];
                __syncthreads();
                if (f + PF < ntot) fetch(s);
                lptr Ap = A_LDS ? apanels + kt * (BM * 128) : As;
#pragma unroll
                for (int ks = 0; ks < 2; ++ks) {
                    bf16x8 af[MI], bfr[NI];
                    const int ch = 4 * ks + (lane >> 4);
#pragma unroll
                    for (int mi = 0; mi < MI; ++mi) af[mi] = *(const LAS bf16x8*)(Ap + swz_off(wm * (BM / WM) + 16 * mi + (lane & 15), ch));
#pragma unroll
                    for (int ni = 0; ni < NI; ++ni) bfr[ni] = *(const LAS bf16x8*)(Bs + swz_off(wn * (BN / WN) + 16 * ni + (lane & 15), ch));
#pragma unroll
                    for (int mi = 0; mi < MI; ++mi)
#pragma unroll
                        for (int ni = 0; ni < NI; ++ni) acc[mi][ni] = mfma16(bfr[ni], af[mi], acc[mi][ni]);
                }
                if (++kt == nk) {
                    epi(pn, acc);
#pragma unroll
                    for (int mi = 0; mi < MI; ++mi)
#pragma unroll
                        for (int ni = 0; ni < NI; ++ni) acc[mi][ni] = (f32x4){0.f, 0.f, 0.f, 0.f};
                    kt = 0; ++pn;
                }
            }
        }
    }
};
template <int MI, int NI> DI void zero_acc(f32x4 (&acc)[MI][NI]) {
#pragma unroll
    for (int a = 0; a < MI; ++a)
#pragma unroll
        for (int b = 0; b < NI; ++b) acc[a][b] = (f32x4){0.f, 0.f, 0.f, 0.f};
}

DI void rope4(f32x4& a, f32x4& b, const float* tab, int prow, int pcol, int g) {
    const int pos = (g < 2) ? prow : pcol; const int f0 = 4 * (g & 1);
    const f32x4 cs = *(const f32x4*)(tab + pos * 16 + f0), sn = *(const f32x4*)(tab + pos * 16 + 8 + f0);
    const f32x4 ya = a * cs - b * sn, yb = a * sn + b * cs; a = ya; b = yb;
}

namespace pg8 {
#define PG8_LAS __attribute__((address_space(3)))
typedef unsigned short bf16_t;
typedef short bf16x8 __attribute__((ext_vector_type(8)));
typedef float f32x4 __attribute__((ext_vector_type(4)));
typedef unsigned u32x4 __attribute__((ext_vector_type(4)));
constexpr int BM = 256, BK = 64, HALF = 128, HTB = HALF * BK * 2  , STAGE_BYTES = 8 * HTB, NXCD = 8, WGM = 8;

__host__ __device__ __forceinline__ int lds_byte(int r, int c) { const int st = (r >> 4) * 2 + (c >> 5), rr = r & 15, cc = c & 31, ob = rr * 64 + cc * 2; return st * 1024 + (ob ^ (((ob >> 9) & 1) << 5)); }
__host__ __device__ __forceinline__ void stage_rc(int b, int& R, int& C) { const int st = b / 1024, sb = b % 1024, swz = sb ^ (((sb >> 9) & 1) << 5); R = (st >> 1) * 16 + swz / 64; C = (st & 1) * 32 + (swz % 64) / 2; }
__host__ __device__ __forceinline__ int perm32(int rho) { const int n = rho >> 4, i = rho & 15; return 8 * (i >> 2) + 4 * n + (i & 3); }

struct Unit { int pm, pn; };
struct Gemm { const bf16_t* A; const bf16_t* Bt; int M, N, K; };

struct StaticOrder {
    int nM, nN, nwg, G, c;
    __host__ __device__ void init(int M, int N, int G_, int c_) { nM = M / BM; nN = N / BM; nwg = nM * nN; G = G_; c = c_; }
    __host__ __device__ bool next(int i, Unit& u) const {
        const long L = (long)i * G + c; if (L >= nwg) return false;
        int wgid = (int)L; { const int q = nwg / NXCD, r = nwg % NXCD, xcd = wgid % NXCD, off = wgid / NXCD; wgid = (xcd < r ? xcd * (q + 1) : r * (q + 1) + (xcd - r) * q) + off; }
        const int nig = WGM * nN, gid = wgid / nig, fm = gid * WGM, gsz = (nM - fm) < WGM ? (nM - fm) : WGM;
        u.pm = fm + ((wgid % nig) % gsz); u.pn = (wgid % nig) / gsz; return true;
    }
    __device__ __forceinline__ void a_ready(const Unit&) const {}
    __device__ __forceinline__ void done(const Unit&) const {}
};

template <class Epi, class Sched, bool ALIGN_EPI = false, bool SP2 = false>
__device__ __forceinline__ void gemm_phase(PG8_LAS unsigned char* lds, const Gemm g, const Sched& S, const Epi& E) {
    const int tid = otid(), wid = __builtin_amdgcn_readfirstlane(tid >> 6), lane = tid & 63, wr = wid >> 2, wc = wid & 3, fr = lane & 15, fq = lane >> 4;
    const int K = g.K, nt = K / BK;
    unsigned voffA[2], voffB[2];
#pragma unroll
    for (int i = 0; i < 2; ++i) { int R, C; stage_rc(tid * 16 + i * 8192, R, C); const int Rb = Epi::PERM ? ((R & ~31) + perm32(R & 31)) : R;
        voffA[i] = (unsigned)(R * K + C) * 2u; voffB[i] = (unsigned)(Rb * K + C) * 2u; }
    const size_t kstep = (size_t)(BK * 2);
    const size_t hstep = (size_t)HALF * K * 2;
    const size_t tstep = 2 * hstep;
    const unsigned ldsw = (unsigned)wid * 1024u;
    const int aoff = lds_byte(wr * 64 + fr, fq * 8), boff = lds_byte(wc * 32 + fr, fq * 8);
#define PG8_SA(b, h) (((b) * 2 + (h)) * HTB)
#define PG8_SB(b, h) ((4 + (b) * 2 + (h)) * HTB)
#define PG8_STAGE(bufoff, gbase, voff) do { _Pragma("unroll") for (int _i = 0; _i < 2; ++_i) \
        __builtin_amdgcn_global_load_lds((const unsigned*)((const char*)(gbase) + (voff)[_i]), (PG8_LAS unsigned*)(lds + (bufoff) + ldsw + _i * 8192), 16, 0, 0); } while (0)
#define PG8_LDA(dst, b, h) do { _Pragma("unroll") for (int m = 0; m < 4; ++m) _Pragma("unroll") for (int k = 0; k < 2; ++k) dst[m][k] = *(const PG8_LAS bf16x8*)(lds + PG8_SA(b, h) + aoff + m * 2048 + k * 1024); } while (0)
#define PG8_LDB(dst, b, h) do { _Pragma("unroll") for (int n = 0; n < 2; ++n) _Pragma("unroll") for (int k = 0; k < 2; ++k) dst[n][k] = *(const PG8_LAS bf16x8*)(lds + PG8_SB(b, h) + boff + n * 2048 + k * 1024); } while (0)
#define PG8_MMA(ai, bj, At, Bt) do { __builtin_amdgcn_s_setprio(1); _Pragma("unroll") for (int m = 0; m < 4; ++m) _Pragma("unroll") for (int n = 0; n < 2; ++n) _Pragma("unroll") for (int k = 0; k < 2; ++k) \
        acc[ai][bj][m][n] = __builtin_amdgcn_mfma_f32_16x16x32_bf16(Bt[n][k], At[m][k], acc[ai][bj][m][n], 0, 0, 0); __builtin_amdgcn_s_setprio(0); } while (0)
#define PG8_WAIT_V(n) asm volatile("s_waitcnt vmcnt(" #n ")" ::: "memory")
#define PG8_WAIT_L(n) asm volatile("s_waitcnt lgkmcnt(" #n ")" ::: "memory")
#define PG8_BAR __builtin_amdgcn_s_barrier()
#define PG8_SCHED __builtin_amdgcn_sched_barrier(0)
    Unit cur, nxt; int ui = 0;
    if (!S.next(0, cur)) return;
    f32x4 acc[2][2][4][2];
#pragma unroll
    for (int a = 0; a < 2; ++a)
#pragma unroll
        for (int b = 0; b < 2; ++b)
#pragma unroll
            for (int m = 0; m < 4; ++m)
#pragma unroll
                for (int n = 0; n < 2; ++n) acc[a][b][m][n] = (f32x4){0.f, 0.f, 0.f, 0.f};
    bf16x8 At[4][2], B0[2][2], B1[2][2];
    const char* cA = (const char*)g.A + (size_t)cur.pm * tstep; const char* cB = (const char*)g.Bt + (size_t)cur.pn * tstep;
    S.a_ready(cur);
    if constexpr (SP2) {
        PG8_STAGE(PG8_SB(0, 0), cB, voffB); PG8_STAGE(PG8_SB(0, 1), cB + hstep, voffB); PG8_STAGE(PG8_SA(0, 0), cA, voffA); PG8_STAGE(PG8_SA(0, 1), cA + hstep, voffA);
        if (wr == 1) PG8_BAR;
        PG8_WAIT_V(2); PG8_BAR;
        PG8_STAGE(PG8_SB(1, 0), cB + kstep, voffB); PG8_STAGE(PG8_SA(1, 0), cA + kstep, voffA); PG8_STAGE(PG8_SB(1, 1), cB + hstep + kstep, voffB);
        PG8_WAIT_V(6); PG8_BAR;
    } else {
        PG8_STAGE(PG8_SB(0, 0), cB, voffB); PG8_STAGE(PG8_SA(0, 0), cA, voffA); PG8_STAGE(PG8_SB(0, 1), cB + hstep, voffB); PG8_STAGE(PG8_SA(0, 1), cA + hstep, voffA);
        if (wr == 1) PG8_BAR;
        PG8_WAIT_V(4); PG8_BAR;
        PG8_STAGE(PG8_SB(1, 0), cB + kstep, voffB); PG8_STAGE(PG8_SA(1, 0), cA + kstep, voffA); PG8_STAGE(PG8_SB(1, 1), cB + hstep + kstep, voffB);
        PG8_WAIT_V(6); PG8_BAR;
    }
    for (;;) {
        const bool has_next = S.next(ui + 1, nxt);
        const char* nA = has_next ? (const char*)g.A + (size_t)nxt.pm * tstep : cA; const char* nB = has_next ? (const char*)g.Bt + (size_t)nxt.pn * tstep : cB;
        for (int t = 0; t < nt; t += 2) {
            const bool last = (t == nt - 2);
            const char* a1 = cA + (size_t)(t + 1) * kstep;
            const char* a2 = last ? nA : cA + (size_t)(t + 2) * kstep; const char* b2 = last ? nB : cB + (size_t)(t + 2) * kstep;
            const char* a3 = a2 + kstep; const char* b3 = b2 + kstep;
            if (last && has_next) S.a_ready(nxt);
            if constexpr (SP2) {
            PG8_LDB(B0, 0, 0); PG8_LDB(B1, 0, 1); PG8_SCHED; PG8_LDA(At, 0, 0); PG8_STAGE(PG8_SA(1, 1), a1 + hstep, voffA);
            PG8_WAIT_V(8); PG8_WAIT_L(0); PG8_BAR; PG8_MMA(0, 0, At, B0); PG8_MMA(0, 1, At, B1); PG8_BAR; PG8_SCHED;
            PG8_LDA(At, 0, 1); PG8_STAGE(PG8_SB(0, 0), b2, voffB); PG8_STAGE(PG8_SB(0, 1), b2 + hstep, voffB); PG8_STAGE(PG8_SA(0, 0), a2, voffA);
            PG8_WAIT_V(8); PG8_WAIT_L(0); PG8_BAR; PG8_MMA(1, 0, At, B0); PG8_MMA(1, 1, At, B1); PG8_BAR; PG8_SCHED;
            PG8_LDB(B0, 1, 0); PG8_LDB(B1, 1, 1); PG8_SCHED; PG8_LDA(At, 1, 0); PG8_STAGE(PG8_SA(0, 1), a2 + hstep, voffA);
            PG8_WAIT_V(8); PG8_WAIT_L(0); PG8_BAR; PG8_MMA(0, 0, At, B0); PG8_MMA(0, 1, At, B1); PG8_BAR; PG8_SCHED;
            PG8_LDA(At, 1, 1); PG8_STAGE(PG8_SB(1, 0), b3, voffB); PG8_STAGE(PG8_SB(1, 1), b3 + hstep, voffB); PG8_STAGE(PG8_SA(1, 0), a3, voffA);
            PG8_WAIT_V(8); PG8_WAIT_L(0); PG8_BAR; PG8_MMA(1, 0, At, B0); PG8_MMA(1, 1, At, B1); PG8_BAR; PG8_SCHED;
            } else {
            PG8_LDB(B0, 0, 0); PG8_SCHED; PG8_LDA(At, 0, 0); PG8_STAGE(PG8_SA(1, 1), a1 + hstep, voffA);
            PG8_WAIT_L(8); PG8_BAR; PG8_WAIT_L(0); PG8_MMA(0, 0, At, B0); PG8_BAR; PG8_SCHED;
            PG8_LDB(B1, 0, 1); PG8_STAGE(PG8_SB(0, 0), b2, voffB);
            PG8_BAR; PG8_WAIT_L(0); PG8_MMA(0, 1, At, B1); PG8_BAR;
            PG8_LDA(At, 0, 1); PG8_STAGE(PG8_SA(0, 0), a2, voffA);
            PG8_BAR; PG8_WAIT_L(0); PG8_MMA(1, 0, At, B0); PG8_BAR; PG8_SCHED;
            PG8_STAGE(PG8_SB(0, 1), b2 + hstep, voffB);
            PG8_WAIT_V(6); PG8_BAR; PG8_MMA(1, 1, At, B1); PG8_BAR;
            PG8_LDB(B0, 1, 0); PG8_SCHED; PG8_LDA(At, 1, 0); PG8_STAGE(PG8_SA(0, 1), a2 + hstep, voffA);
            PG8_WAIT_L(8); PG8_BAR; PG8_WAIT_L(0); PG8_MMA(0, 0, At, B0); PG8_BAR; PG8_SCHED;
            PG8_LDB(B1, 1, 1); PG8_STAGE(PG8_SB(1, 0), b3, voffB);
            PG8_BAR; PG8_WAIT_L(0); PG8_MMA(0, 1, At, B1); PG8_BAR;
            PG8_LDA(At, 1, 1); PG8_STAGE(PG8_SA(1, 0), a3, voffA);
            PG8_BAR; PG8_WAIT_L(0); PG8_MMA(1, 0, At, B0); PG8_BAR; PG8_SCHED;
            PG8_STAGE(PG8_SB(1, 1), b3 + hstep, voffB);
            PG8_WAIT_V(6); PG8_BAR; PG8_MMA(1, 1, At, B1); PG8_BAR;
            }
        }
        if constexpr (ALIGN_EPI) { if (wr == 0) PG8_BAR; }
        if constexpr (!Epi::AFTER_DRAIN) { E(acc, cur, wr, wc, fr, fq); S.done(cur); }
        if (!has_next) break;
#pragma unroll
        for (int a = 0; a < 2; ++a)
#pragma unroll
            for (int b = 0; b < 2; ++b)
#pragma unroll
                for (int m = 0; m < 4; ++m)
#pragma unroll
                    for (int n = 0; n < 2; ++n) acc[a][b][m][n] = (f32x4){0.f, 0.f, 0.f, 0.f};
        cur = nxt; cA = nA; cB = nB; ++ui;
        if constexpr (ALIGN_EPI) { if (wr == 1) PG8_BAR; }
    }
    PG8_WAIT_V(0);
    if constexpr (!ALIGN_EPI) { if (wr == 0) PG8_BAR; }
    PG8_BAR;
    if constexpr (Epi::AFTER_DRAIN) { E.fused(acc, cur, wr, wc, fr, fq, lds, wid, lane); S.done(cur); }
#undef PG8_SA
#undef PG8_SB
#undef PG8_STAGE
#undef PG8_LDA
#undef PG8_LDB
#undef PG8_MMA
#undef PG8_WAIT_V
#undef PG8_WAIT_L
#undef PG8_BAR
#undef PG8_SCHED
}
}

#ifndef PG8_SP2
#define PG8_SP2 true
#endif
struct EpiInproj {
    static constexpr bool PERM = false, AFTER_DRAIN = false;
    unsigned char* ws;
    DI void operator()(const f32x4 (&acc)[2][2][4][2], const pg8::Unit& u, int wr, int wc, int fr, int fq) const {
        const float* tab = (const float*)(ws + WS_TAB);
        bf16_t* U = (bf16_t*)(ws + WS_U); bf16_t* RQ = (bf16_t*)(ws + WS_RQ); bf16_t* RK = (bf16_t*)(ws + WS_RK); bf16_t* RV = (bf16_t*)(ws + WS_RV);
        bf16_t* GF = (bf16_t*)(ws + WS_GF); bf16_t* GB = (bf16_t*)(ws + WS_GB); bf16_t* CQ = (bf16_t*)(ws + WS_CQ); bf16_t* CKV = (bf16_t*)(ws + WS_CKV); bf16_t* KR = (bf16_t*)(ws + WS_KR);
        const int g = fq;
#pragma unroll
        for (int ai = 0; ai < 2; ++ai)
#pragma unroll
            for (int m = 0; m < 4; ++m) {
                const int t = u.pm * 256 + ai * 128 + wr * 64 + m * 16 + fr;
                const int lat = t - CTX; const bool isl = lat >= 0; const int prow = isl ? (lat >> 6) : 0, pcol = isl ? (lat & 63) : 0;
#pragma unroll
                for (int bj = 0; bj < 2; ++bj) {
                    const int c32 = u.pn * 256 + bj * 128 + wc * 32;
                    f32x4 a = acc[ai][bj][m][0], b = acc[ai][bj][m][1];
                    if (c32 < 512) {
                        f32x4 o;
#pragma unroll
                        for (int j = 0; j < 4; ++j) o[j] = a[j] * fsigm(b[j]);
                        *(u32x2*)(U + (size_t)t * 256 + (c32 >> 1) + 4 * g) = pack4(o);
                    } else if (c32 < 896) {
                        const bool isq = c32 < 704; const int hb = (c32 - (isq ? 512 : 704));
                        if (isl) rope4(a, b, tab, prow, pcol, g);
                        const float sc = isq ? 1.f : 0.17677669529663687f;
                        bf16_t* dst = (isq ? RQ : RK) + (size_t)t * 192 + hb + 4 * g;
                        *(u32x2*)(dst) = pack4(a * sc); *(u32x2*)(dst + 16) = pack4(b * sc);
                    } else if (c32 < 1280) {
                        bf16_t* dst = RV + (size_t)t * 384 + (c32 - 896) + 4 * g; *(u32x2*)(dst) = pack4(a); *(u32x2*)(dst + 16) = pack4(b);
                    } else if (c32 < 2048) {
                        const bool isf = c32 < 1664;
                        bf16_t* dst = (isf ? GF : GB) + (size_t)t * 384 + (c32 - (isf ? 1280 : 1664)) + 4 * g;
                        f32x4 oa, ob;
#pragma unroll
                        for (int j = 0; j < 4; ++j) { oa[j] = fsilu(a[j]); ob[j] = fsilu(b[j]); }
                        *(u32x2*)(dst) = pack4(oa); *(u32x2*)(dst + 16) = pack4(ob);
                    } else if (c32 < 2240) {
                        bf16_t* dst = CQ + (size_t)t * 192 + (c32 - 2048) + 4 * g; *(u32x2*)(dst) = pack4(a); *(u32x2*)(dst + 16) = pack4(b);
                    } else if (c32 < 2368) {
                        bf16_t* dst = CKV + (size_t)t * 128 + (c32 - 2240) + 4 * g; *(u32x2*)(dst) = pack4(a); *(u32x2*)(dst + 16) = pack4(b);
                    } else if (c32 < 2400) {
                        if (isl) rope4(a, b, tab, prow, pcol, g);
                        bf16_t* dst = KR + (size_t)t * 32 + 4 * g; *(u32x2*)(dst) = pack4(a); *(u32x2*)(dst + 16) = pack4(b);
                    }
                }
            }
    }
};
DI void phase_inproj(const Params& p, lptr lds, int l) {
    pg8::Gemm g{catp(p), (const bf16_t*)(p.ws + WS_WIN) + (size_t)l * NINP * D, T, NINP, D};
    pg8::StaticOrder S; S.init(T, NINP, (int)gridDim.x, obid());
    EpiInproj E{p.ws};
    pg8::gemm_phase<EpiInproj, pg8::StaticOrder, true, PG8_SP2>(lds, g, S, E);
    if (l == 0 && defer_moe_weights0() && obid() >= inproj_first_idle()) {
        const int tid = otid(), lane = tid & 63, wave = __builtin_amdgcn_readfirstlane(tid >> 6);
        const int nidle = 256 - inproj_first_idle();
        __syncthreads();
        LAS unsigned* scr = (LAS unsigned*)(lds + wave * 8448);
#pragma unroll 1
        for (int it = (obid() - inproj_first_idle()) * NWAVES + wave; it < I_MOE; it += nidle * NWAVES) weight_item(p, scr, 0, I_SMALL + it, lane);
    }
}

template <bool ISQ>
DI void mla_up_tile(const Params& p, lptr lds, int l, int mt, int nt) {
    typedef GemmTile<256, 128, 4, 2, false, 3> G;
    constexpr int KD = ISQ ? 192 : 128;
    const int tid = otid(), lane = tid & 63, wave = tid >> 6, wm = wave >> 1, wn = wave & 1, il = lane & 15, g = lane >> 4;
    unsigned char* ws = p.ws;
    const bf16_t* A = (const bf16_t*)(ws + (ISQ ? WS_CQ : WS_CKV));
    const bf16_t* W = ISQ ? (const bf16_t*)(ws + WS_WUQ) + (size_t)l * 640 * 192 : (const bf16_t*)(ws + WS_WUKV) + (size_t)l * 768 * 128;
    const float* tab = (const float*)(ws + WS_TAB);
    LAS float* rs = (LAS float*)(lds + 49152);
    const int m0 = mt * 256, n0 = nt * 128;
    __syncthreads();
    f32x4 acc[4][4]; zero_acc(acc);
    const bf16_t* arow[4];
#pragma unroll
    for (int q = 0; q < 4; ++q) arow[q] = A + (size_t)(m0 + (tid >> 3) + 64 * q) * KD + (tid & 7) * 8;
    G::run(acc, lds, arow, lds, W + (size_t)n0 * KD, KD, KD, [&]() __attribute__((always_inline)) {
        if (tid < 256) {
            const bf16_t* r = A + (size_t)(m0 + tid) * KD; float ss = 0.f;
#pragma unroll
            for (int c = 0; c < KD / 8; ++c) {
                const u32x4 v = *(const u32x4*)(r + c * 8);
                ss += bflo(v.x) * bflo(v.x) + bfhi(v.x) * bfhi(v.x) + bflo(v.y) * bflo(v.y) + bfhi(v.y) * bfhi(v.y)
                    + bflo(v.z) * bflo(v.z) + bfhi(v.z) * bfhi(v.z) + bflo(v.w) * bflo(v.w) + bfhi(v.w) * bfhi(v.w);
            }
            rs[tid] = 1.f / sqrtf(ss * (1.f / KD) + 1e-6f);
        }
    });
    __syncthreads();
    bf16_t* QB = (bf16_t*)(ws + WS_QB); bf16_t* KB = (bf16_t*)(ws + WS_KB); bf16_t* VT = (bf16_t*)(ws + WS_VT);
#pragma unroll
    for (int mi = 0; mi < 4; ++mi) {
        const int rloc = wm * 64 + mi * 16 + il; const int t = m0 + rloc;
        const float r = rs[rloc];
        const int lat = t - CTX; const bool isl = lat >= 0; const int prow = isl ? (lat >> 6) : 0, pcol = isl ? (lat & 63) : 0;
#pragma unroll
        for (int u2 = 0; u2 < 2; ++u2) {
            const int c32 = n0 + wn * 64 + 32 * u2;
            f32x4 a = acc[mi][2 * u2] * r, b = acc[mi][2 * u2 + 1] * r;
            if (ISQ) {
                if (c32 < 576) {
                    const int h = c32 / 96, d0 = c32 % 96;
                    if (d0 == 64 && isl) rope4(a, b, tab, prow, pcol, g);
#if MK_FP8
                    unsigned char* dst = (unsigned char*)QB + ((size_t)h * T + t) * 96 + d0 + 4 * g;
                    *(unsigned*)(dst) = pk4_fp8(a * QSCALE); *(unsigned*)(dst + 16) = pk4_fp8(b * QSCALE);
#else
                    bf16_t* dst = QB + ((size_t)h * T + t) * 96 + d0 + 4 * g;
                    *(u32x2*)(dst) = pack4(a * QSCALE); *(u32x2*)(dst + 16) = pack4(b * QSCALE);
#endif
                }
            } else {
                const int h = c32 >> 7, d0 = c32 & 127;
#if MK_FP8
                if (d0 < 64) {
                    unsigned char* dst = (unsigned char*)KB + ((size_t)h * T + t) * 96 + d0 + 4 * g; *(unsigned*)(dst) = pk4_fp8(a); *(unsigned*)(dst + 16) = pk4_fp8(b);
                } else {
                    unsigned char* dst = (unsigned char*)VT + ((size_t)h * T + t) * 64 + (d0 - 64) + 4 * g; *(unsigned*)(dst) = pk4_fp8(a); *(unsigned*)(dst + 16) = pk4_fp8(b);
                }
#else
                if (d0 < 64) {
                    bf16_t* dst = KB + ((size_t)h * T + t) * 96 + d0 + 4 * g; *(u32x2*)(dst) = pack4(a); *(u32x2*)(dst + 16) = pack4(b);
                } else {
                    bf16_t* dst = VT + ((size_t)h * 64 + (d0 - 64) + 4 * g) * T + t;
#pragma unroll
                    for (int j = 0; j < 4; ++j) { dst[(size_t)j * T] = (bf16_t)f2bf(a[j]); dst[(size_t)(16 + j) * T] = (bf16_t)f2bf(b[j]); }
                }
#endif
            }
        }
    }
    if (!ISQ && nt == 0) {
        const bf16_t* KR = (const bf16_t*)(ws + WS_KR);
        for (int i = tid; i < 256 * 4; i += NTHREADS) {
            const int rr = i >> 2, c = i & 3; const u32x4 v = *(const u32x4*)(KR + (size_t)(m0 + rr) * 32 + c * 8);
#if MK_FP8
            u32x2 w; w.x = pk4_fp8((f32x4){bflo(v.x), bfhi(v.x), bflo(v.y), bfhi(v.y)}); w.y = pk4_fp8((f32x4){bflo(v.z), bfhi(v.z), bflo(v.w), bfhi(v.w)});
#pragma unroll
            for (int h = 0; h < 6; ++h) *(u32x2*)((unsigned char*)KB + ((size_t)h * T + m0 + rr) * 96 + 64 + c * 8) = w;
#else
#pragma unroll
            for (int h = 0; h < 6; ++h) *(u32x4*)(KB + ((size_t)h * T + m0 + rr) * 96 + 64 + c * 8) = v;
#endif
        }
    }
}

struct DsRaw { u32x2 va[2], vb[2], ka, kb; };
DI void dstate_load(const Params& p, int c, int h, DsRaw& r) {
    const int tid = otid(); unsigned char* ws = p.ws;
    const bf16_t* RK = (const bf16_t*)(ws + WS_RK); const bf16_t* RV = (const bf16_t*)(ws + WS_RV);
    const int t0 = c * 128;
#pragma unroll
    for (int q = 0; q < 2; ++q) {
        const int idx = tid + 512 * q, rp = idx >> 4, c4 = (idx & 15) * 4;
        r.va[q] = *(const u32x2*)(RV + (size_t)(t0 + 2 * rp) * 384 + h * 64 + c4); r.vb[q] = *(const u32x2*)(RV + (size_t)(t0 + 2 * rp + 1) * 384 + h * 64 + c4);
    }
    { const int rp = tid >> 3, c4 = (tid & 7) * 4;
      r.ka = *(const u32x2*)(RK + (size_t)(t0 + 2 * rp) * 192 + h * 32 + c4); r.kb = *(const u32x2*)(RK + (size_t)(t0 + 2 * rp + 1) * 192 + h * 32 + c4); }
}
DI void dstate_item(const Params& p, lptr lds, int c, int h, DsRaw& raw, bool has_next, int cn, int hn) {
    const int tid = otid(), lane = tid & 63, wave = tid >> 6, il = lane & 15, g = lane >> 4; unsigned char* ws = p.ws;
    constexpr int RS = 272, OVT = 0, OKF = 64 * RS, OKB = OKF + 32 * RS;
    __syncthreads();
#pragma unroll
    for (int q = 0; q < 2; ++q) {
        const int idx = tid + 512 * q, rp = idx >> 4, c4 = (idx & 15) * 4;
        const u32x2 a = raw.va[q], b = raw.vb[q];
        *(LAS unsigned*)(lds + OVT + (c4 + 0) * RS + rp * 4) = (a.x & 0xffffu) | (b.x << 16);
        *(LAS unsigned*)(lds + OVT + (c4 + 1) * RS + rp * 4) = (a.x >> 16) | (b.x & 0xffff0000u);
        *(LAS unsigned*)(lds + OVT + (c4 + 2) * RS + rp * 4) = (a.y & 0xffffu) | (b.y << 16);
        *(LAS unsigned*)(lds + OVT + (c4 + 3) * RS + rp * 4) = (a.y >> 16) | (b.y & 0xffff0000u);
    }
    {
        const int rp = tid >> 3, c4 = (tid & 7) * 4;
        const float lgf = log2f(gamma_f(h)), lgb = log2f(gamma_f(5 - h));
        const float wf0 = exp2f((float)(127 - 2 * rp) * lgf), wf1 = exp2f((float)(126 - 2 * rp) * lgf), wb0 = exp2f((float)(2 * rp) * lgb), wb1 = exp2f((float)(2 * rp + 1) * lgb);
        const u32x2 a = raw.ka, b = raw.kb;
        const float a0 = bflo(a.x), a1 = bfhi(a.x), a2 = bflo(a.y), a3 = bfhi(a.y), b0 = bflo(b.x), b1 = bfhi(b.x), b2 = bflo(b.y), b3 = bfhi(b.y);
        *(LAS unsigned*)(lds + OKF + (c4 + 0) * RS + rp * 4) = pk2(a0 * wf0, b0 * wf1); *(LAS unsigned*)(lds + OKF + (c4 + 1) * RS + rp * 4) = pk2(a1 * wf0, b1 * wf1);
        *(LAS unsigned*)(lds + OKF + (c4 + 2) * RS + rp * 4) = pk2(a2 * wf0, b2 * wf1); *(LAS unsigned*)(lds + OKF + (c4 + 3) * RS + rp * 4) = pk2(a3 * wf0, b3 * wf1);
        *(LAS unsigned*)(lds + OKB + (c4 + 0) * RS + rp * 4) = pk2(a0 * wb0, b0 * wb1); *(LAS unsigned*)(lds + OKB + (c4 + 1) * RS + rp * 4) = pk2(a1 * wb0, b1 * wb1);
        *(LAS unsigned*)(lds + OKB + (c4 + 2) * RS + rp * 4) = pk2(a2 * wb0, b2 * wb1); *(LAS unsigned*)(lds + OKB + (c4 + 3) * RS + rp * 4) = pk2(a3 * wb0, b3 * wb1);
    }
    __syncthreads();
    if (has_next) dstate_load(p, cn, hn, raw);
    const int et = wave & 3, dt = wave >> 2;
    f32x4 af = {0.f, 0.f, 0.f, 0.f}, ab = {0.f, 0.f, 0.f, 0.f};
#pragma unroll
    for (int s4 = 0; s4 < 4; ++s4) {
        const bf16x8 vf = *(const LAS bf16x8*)(lds + OVT + (16 * et + il) * RS + 64 * s4 + 16 * g);
        const bf16x8 kf = *(const LAS bf16x8*)(lds + OKF + (16 * dt + il) * RS + 64 * s4 + 16 * g), kb = *(const LAS bf16x8*)(lds + OKB + (16 * dt + il) * RS + 64 * s4 + 16 * g);
        af = mfma16(vf, kf, af); ab = mfma16(vf, kb, ab);
    }
    float* DS = (float*)(ws + WS_DS);
    *(f32x4*)(DS + (((size_t)0 * NCH + c) * 6 + h) * 2048 + (16 * dt + il) * 64 + 16 * et + 4 * g) = af;
    *(f32x4*)(DS + (((size_t)1 * NCH + c) * 6 + h) * 2048 + (16 * dt + il) * 64 + 16 * et + 4 * g) = ab;
}

DI void conv_item(const Params& p, lptr lds, int l, int tile) {
    const int tid = otid(), lane = tid & 63, wave = tid >> 6; unsigned char* ws = p.ws;
    const bf16_t* U = (const bf16_t*)(ws + WS_U);
    const int t0 = tile * 64; const int seq_lo = (t0 < CTX) ? 0 : CTX, seq_hi = (t0 < CTX) ? CTX : T;
    __syncthreads();
    for (int idx = tid; idx < 94 * 32; idx += NTHREADS) {
        const int row = idx >> 5, ch = idx & 31; const int tok = t0 - 15 + row;
        u32x4 v = {0u, 0u, 0u, 0u};
        if (tok >= seq_lo && tok < seq_hi) v = *(const u32x4*)(U + (size_t)tok * 256 + ch * 8);
        *(LAS u32x4*)(lds + row * 512 + ch * 16) = v;
    }
    const f32x4 bias = *(const f32x4*)(p.conv_b + l * 256 + 4 * lane);
    const f32x4 lw = *(const f32x4*)(p.conv_ln_w + l * 256 + 4 * lane), lb = *(const f32x4*)(p.conv_ln_b + l * 256 + 4 * lane);
    __syncthreads();
    f32x4 acc[8];
#pragma unroll
    for (int i = 0; i < 8; ++i) acc[i] = bias;
#pragma unroll 1
    for (int ps = 0; ps < 4; ++ps) {
        const int k0 = ps * 8;
        f32x4 w[8];
#pragma unroll
        for (int k = 0; k < 8; ++k) w[k] = (k0 + k < 31) ? *(const f32x4*)(p.conv_dw + ((size_t)l * 31 + k0 + k) * 256 + 4 * lane) : (f32x4){0.f, 0.f, 0.f, 0.f};
#pragma unroll
        for (int rq = 0; rq < 15; ++rq) {
            const int rr = k0 + rq;
            if (rr > 37) continue;
            const u32x2 uu = *(const LAS u32x2*)(lds + (wave * 8 + rr) * 512 + lane * 8);
            const f32x4 u4 = {bflo(uu.x), bfhi(uu.x), bflo(uu.y), bfhi(uu.y)};
#pragma unroll
            for (int i = 0; i < 8; ++i) { const int k = rq - i; if (k >= 0 && k < 8) acc[i] += u4 * w[k]; }
        }
        asm volatile("" ::: "memory");
    }
    bf16_t* CAT = catp(p);
#pragma unroll
    for (int i = 0; i < 8; ++i) {
        const f32x4 a = acc[i];
        const float mean = wave_sum((a[0] + a[1]) + (a[2] + a[3])) * (1.f / 256.f);
        const f32x4 dd = a - mean;
        const float var = wave_sum((dd[0] * dd[0] + dd[1] * dd[1]) + (dd[2] * dd[2] + dd[3] * dd[3])) * (1.f / 256.f);
        const float rstd = 1.f / sqrtf(var + 1e-6f);
        f32x4 o;
#pragma unroll
        for (int j = 0; j < 4; ++j) o[j] = fsilu(dd[j] * rstd * lw[j] + lb[j]);
        *(u32x2*)(CAT + (size_t)(t0 + wave * 8 + i) * D + 4 * lane) = pack4(o);
    }
}

DI void phase_pc(const Params& p, lptr lds, int l) {
    constexpr int N_Q = 65 * 5, N_KV = 65 * 6, N_DS = NCH * 6, N_CV = T / 64;
    constexpr int TOTAL = N_Q + N_KV + N_DS + N_CV;
    DsRaw dr; bool dr_valid = false;
    const int G = gridDim.x;
#pragma unroll 1
    for (int it = obid(); it < TOTAL; it += G) {
        int r = it;
        if (r < N_Q) { if (!(l == DEPTH - 1 && r < 5)) mla_up_tile<true>(p, lds, l, r / 5, r % 5); continue; } r -= N_Q;
        if (r < N_KV) { mla_up_tile<false>(p, lds, l, r / 6, r % 6); continue; } r -= N_KV;
        if (r < N_DS) {
            if (!dr_valid) dstate_load(p, r / 6, r % 6, dr);
            const int rn = r + G; const bool hn = rn < N_DS;
            dstate_item(p, lds, r / 6, r % 6, dr, hn, hn ? rn / 6 : 0, hn ? rn % 6 : 0); dr_valid = hn; continue;
        }
        r -= N_DS;
        if (!(l == DEPTH - 1 && r < CTX / 64)) conv_item(p, lds, l, r);
    }
}

#if MK_FP8
constexpr int K8_B = 128 * 112, V8_B = 64 * 144;
DI i32x8 cat8(u32x4 a, u32x4 b) { i32x8 r; r[0] = (int)a.x; r[1] = (int)a.y; r[2] = (int)a.z; r[3] = (int)a.w; r[4] = (int)b.x; r[5] = (int)b.y; r[6] = (int)b.z; r[7] = (int)b.w; return r; }
DI void attn_unit(const Params& p, lptr lds, int h, int q_t0, int kt0, int nkt, int part) {
    const int tid = otid(), lane = tid & 63, wave = tid >> 6, r = lane & 31, hh = lane >> 5;
    unsigned char* ws = p.ws;
    const unsigned char* Qg = ws + WS_QB + ((size_t)h * T + q_t0 + wave * 32 + r) * 96;
    const unsigned char* Kg = ws + WS_KB + (size_t)h * T * 96 + (size_t)kt0 * 12288; const unsigned kgo = tid * 16;
    const unsigned char* Vg = ws + WS_VT + (size_t)h * T * 64 + (size_t)kt0 * 8192; const unsigned vgo = (4 * (tid >> 4)) * 64 + (tid & 15) * 4;
    const u32x4 z4 = {0u, 0u, 0u, 0u};
    const i32x8 q0 = cat8(*(const u32x4*)(Qg + 32 * hh), *(const u32x4*)(Qg + 32 * hh + 16));
    const i32x8 q1 = hh ? cat8(z4, z4) : cat8(*(const u32x4*)(Qg + 64), *(const u32x4*)(Qg + 80));
    f32x16 o0, o1, o2;
#pragma unroll
    for (int i = 0; i < 16; ++i) { o0[i] = 0.f; o1[i] = 0.f; o2[i] = 0.f; }
    float m = 0.f;
    i32x8 ones;
#pragma unroll
    for (int i = 0; i < 8; ++i) ones[i] = 0x38383838;
    f32x16 negm;
#pragma unroll
    for (int i = 0; i < 16; ++i) negm[i] = 0.f;
    u32x4 rk0, rk1 = z4, sk0, sk1 = z4; unsigned rv[4], sv[4];
    const int ka0 = (tid / 6) * 112 + (tid % 6) * 16, ka1 = ((tid + 512) / 6) * 112 + ((tid + 512) % 6) * 16;
    const int kg = tid >> 4, dg = tid & 15;
    const int va = (4 * dg) * 144 + 32 * (kg >> 3) + 16 * (kg & 1) + 4 * ((kg & 7) >> 1);
#define ATT_GLOAD(kt, rk0, rk1, rv) do { const unsigned char* kb_ = Kg + (size_t)(kt) * 12288; rk0 = *(const u32x4*)(kb_ + kgo); if (tid < 256) rk1 = *(const u32x4*)(kb_ + 8192 + kgo); \
        const unsigned char* vb_ = Vg + (size_t)(kt) * 8192; _Pragma("unroll") for (int i_ = 0; i_ < 4; ++i_) rv[i_] = *(const unsigned*)(vb_ + i_ * 64 + vgo); } while (0)
#define ATT_LSTORE(b, rk0, rk1, rv) do { lptr kb_ = lds + (b) * K8_B; *(LAS u32x4*)(kb_ + ka0) = rk0; if (tid < 256) *(LAS u32x4*)(kb_ + ka1) = rk1; \
        const unsigned lo01_ = __builtin_amdgcn_perm(rv[1], rv[0], 0x05010400u), hi01_ = __builtin_amdgcn_perm(rv[1], rv[0], 0x07030602u); \
        const unsigned lo23_ = __builtin_amdgcn_perm(rv[3], rv[2], 0x05010400u), hi23_ = __builtin_amdgcn_perm(rv[3], rv[2], 0x07030602u); \
        lptr vb_ = lds + 3 * K8_B + (b) * V8_B + va; \
        *(LAS unsigned*)(vb_) = __builtin_amdgcn_perm(lo23_, lo01_, 0x05040100u); *(LAS unsigned*)(vb_ + 144) = __builtin_amdgcn_perm(lo23_, lo01_, 0x07060302u); \
        *(LAS unsigned*)(vb_ + 288) = __builtin_amdgcn_perm(hi23_, hi01_, 0x05040100u); *(LAS unsigned*)(vb_ + 432) = __builtin_amdgcn_perm(hi23_, hi01_, 0x07060302u); } while (0)
    __syncthreads();
    ATT_GLOAD(0, rk0, rk1, rv); ATT_GLOAD(1, sk0, sk1, sv);
    ATT_LSTORE(0, rk0, rk1, rv); ATT_LSTORE(1, sk0, sk1, sv);
    __syncthreads();
    i32x8 kn0, kn1;
    { lptr Kb = lds + r * 112 + hh * 32; lptr Kb1 = lds + r * 112 + 64;
      kn0 = cat8(*(const LAS u32x4*)(Kb), *(const LAS u32x4*)(Kb + 16)); kn1 = cat8(*(const LAS u32x4*)(Kb1), *(const LAS u32x4*)(Kb1 + 16)); }
    auto tile = [&](const int kt, const int b) __attribute__((always_inline)) {
        lptr Kb = lds + b * K8_B + r * 112 + hh * 32; lptr Kb1 = lds + b * K8_B + r * 112 + 64;
        f32x16 s[4];
        s[0] = mfma_mx(kn0, q0, negm); s[0] = mfma_mx(kn1, q1, s[0]);
#pragma unroll
        for (int j = 1; j < 4; ++j) {
            const i32x8 k0 = cat8(*(const LAS u32x4*)(Kb + j * 32 * 112), *(const LAS u32x4*)(Kb + j * 32 * 112 + 16));
            const i32x8 k1 = cat8(*(const LAS u32x4*)(Kb1 + j * 32 * 112), *(const LAS u32x4*)(Kb1 + j * 32 * 112 + 16));
            s[j] = mfma_mx(k0, q0, negm); s[j] = mfma_mx(k1, q1, s[j]);
        }
        float mx = fmaxf(fmaxf(s[0][0], s[1][0]), fmaxf(s[2][0], s[3][0]));
#pragma unroll
        for (int i = 1; i < 16; ++i) { mx = fmaxf(fmaxf(mx, s[0][i]), s[1][i]); mx = fmaxf(fmaxf(mx, s[2][i]), s[3][i]); }
        { auto rr = __builtin_amdgcn_permlane32_swap(__float_as_uint(mx), __float_as_uint(mx), false, false); mx = fmaxf(__uint_as_float(rr[0]), __uint_as_float(rr[1])); }
        if (kt == 0 || __any(mx > 8.f)) {
            const float dl = (kt == 0) ? (mx - 6.f) : fmaxf(mx - 6.f, 0.f); const float alpha = __builtin_amdgcn_exp2f(-dl); m += dl;
#pragma unroll
            for (int i = 0; i < 16; ++i) { o0[i] *= alpha; o1[i] *= alpha; o2[i] *= alpha; negm[i] = -m; }
#pragma unroll
            for (int j = 0; j < 4; ++j)
#pragma unroll
                for (int i = 0; i < 16; ++i) s[j][i] -= dl;
        }
#pragma unroll
        for (int j = 0; j < 4; ++j)
#pragma unroll
            for (int i = 0; i < 16; ++i) s[j][i] = __builtin_amdgcn_exp2f(s[j][i]);
        lptr Vb = lds + 3 * K8_B + b * V8_B + r * 144 + hh * 16;
#pragma unroll
        for (int i2 = 0; i2 < 2; ++i2) {
            i32x8 pb;
#pragma unroll
            for (int q = 0; q < 4; ++q) {
                pb[q] = (int)pk4_fp8((f32x4){s[2 * i2][4 * q], s[2 * i2][4 * q + 1], s[2 * i2][4 * q + 2], s[2 * i2][4 * q + 3]});
                pb[4 + q] = (int)pk4_fp8((f32x4){s[2 * i2 + 1][4 * q], s[2 * i2 + 1][4 * q + 1], s[2 * i2 + 1][4 * q + 2], s[2 * i2 + 1][4 * q + 3]});
            }
            const i32x8 v0 = cat8(*(const LAS u32x4*)(Vb + 64 * i2), *(const LAS u32x4*)(Vb + 64 * i2 + 32));
            const i32x8 v1 = cat8(*(const LAS u32x4*)(Vb + 32 * 144 + 64 * i2), *(const LAS u32x4*)(Vb + 32 * 144 + 64 * i2 + 32));
            o0 = mfma_mx(v0, pb, o0); o1 = mfma_mx(v1, pb, o1); o2 = mfma_mx(ones, pb, o2);
        }
    };
    if (__builtin_amdgcn_readfirstlane(wave) >= 4) __builtin_amdgcn_s_setprio(1);
    int b = 0;
#pragma unroll 1
    for (int kt = 0; kt < nkt; ++kt) {
        if (kt + 2 < nkt) ATT_GLOAD(kt + 2, rk0, rk1, rv);
        tile(kt, b);
        const int b1 = (b == 2) ? 0 : b + 1, b2 = (b1 == 2) ? 0 : b1 + 1;
        if (kt + 1 < nkt) { lptr Kb = lds + b1 * K8_B + r * 112 + hh * 32; lptr Kb1 = lds + b1 * K8_B + r * 112 + 64;
            kn0 = cat8(*(const LAS u32x4*)(Kb), *(const LAS u32x4*)(Kb + 16)); kn1 = cat8(*(const LAS u32x4*)(Kb1), *(const LAS u32x4*)(Kb1 + 16)); }
        if (kt + 2 < nkt) ATT_LSTORE(b2, rk0, rk1, rv);
        b = b1;
        __syncthreads();
    }
#undef ATT_GLOAD
#undef ATT_LSTORE
    __builtin_amdgcn_s_setprio(0);
    const float lt = o2[0]; const float inv = 1.f / lt;
    bf16_t* O;
    if (part < 0) O = catp(p) + (size_t)(q_t0 + wave * 32 + r) * D + 640 + 64 * h + 4 * hh;
    else {
        O = (bf16_t*)(ws + WS_PART) + ((size_t)part * 256 + wave * 32 + r) * 64 + 4 * hh;
        if (hh == 0) { float* st = (float*)(ws + WS_PST) + ((size_t)part * 256 + wave * 32 + r) * 2; st[0] = m; st[1] = lt; }
    }
#pragma unroll
    for (int gq = 0; gq < 4; ++gq) {
        f32x4 a = {o0[4 * gq] * inv, o0[4 * gq + 1] * inv, o0[4 * gq + 2] * inv, o0[4 * gq + 3] * inv};
        f32x4 b = {o1[4 * gq] * inv, o1[4 * gq + 1] * inv, o1[4 * gq + 2] * inv, o1[4 * gq + 3] * inv};
        *(u32x2*)(O + 8 * gq) = pack4(a); *(u32x2*)(O + 32 + 8 * gq) = pack4(b);
    }
}
#else
constexpr int KT_B = 128 * 208, VT_B = 64 * 264;
DI void attn_unit(const Params& p, lptr lds, int h, int q_t0, int kt0, int nkt, int part) {
    const int tid = otid(), lane = tid & 63, wave = tid >> 6, r = lane & 31, hh = lane >> 5;
    unsigned char* ws = p.ws;
    const bf16_t* Qg = (const bf16_t*)(ws + WS_QB) + ((size_t)h * T + q_t0 + wave * 32 + r) * 96;
    const unsigned char* Kg = (const unsigned char*)((const bf16_t*)(ws + WS_KB) + (size_t)h * T * 96) + (size_t)kt0 * 24576 + tid * 16;
    const bf16_t* Vg = (const bf16_t*)(ws + WS_VT) + (size_t)h * 64 * T + (size_t)(tid >> 4) * T + (tid & 15) * 8 + (size_t)kt0 * 128;
    bf16x8 qf[6];
#pragma unroll
    for (int ks = 0; ks < 6; ++ks) qf[ks] = *(const bf16x8*)(Qg + 16 * ks + 8 * hh);
    f32x16 o0, o1;
#pragma unroll
    for (int i = 0; i < 16; ++i) { o0[i] = 0.f; o1[i] = 0.f; }
    float m = -1e30f, lsum = 0.f;
    u32x4 rk[3], rv[2];
    int ka[3];
#pragma unroll
    for (int q = 0; q < 3; ++q) { const int idx = tid + 512 * q; ka[q] = (idx / 12) * 208 + (idx % 12) * 16; }
    const int va = (tid >> 4) * 264 + (tid & 15) * 16;
#define ATT_GLOAD(kt) do { const unsigned char* kb_ = Kg + (size_t)(kt) * 24576; \
        _Pragma("unroll") for (int q_ = 0; q_ < 3; ++q_) rk[q_] = *(const u32x4*)(kb_ + q_ * 8192); \
        rv[0] = *(const u32x4*)(Vg + (kt) * 128); rv[1] = *(const u32x4*)(Vg + (size_t)32 * T + (kt) * 128); } while (0)
#define ATT_LSTORE(b) do { lptr kb_ = lds + (b) * KT_B; \
        _Pragma("unroll") for (int q_ = 0; q_ < 3; ++q_) *(LAS u32x4*)(kb_ + ka[q_]) = rk[q_]; \
        lptr vb_ = lds + 2 * KT_B + (b) * VT_B + va; \
        *(LAS u32x2*)(vb_) = (u32x2){rv[0].x, rv[0].y}; *(LAS u32x2*)(vb_ + 8) = (u32x2){rv[0].z, rv[0].w}; \
        *(LAS u32x2*)(vb_ + 32 * 264) = (u32x2){rv[1].x, rv[1].y}; *(LAS u32x2*)(vb_ + 32 * 264 + 8) = (u32x2){rv[1].z, rv[1].w}; } while (0)
    __syncthreads();
    ATT_GLOAD(0); ATT_LSTORE(0);
    __syncthreads();
    for (int kt = 0; kt < nkt; ++kt) {
        const int b = kt & 1;
        if (kt + 1 < nkt) ATT_GLOAD(kt + 1);
        lptr Kb = lds + b * KT_B + r * 208 + hh * 16;
        f32x16 s[4];
#pragma unroll
        for (int j = 0; j < 4; ++j)
#pragma unroll
            for (int i = 0; i < 16; ++i) s[j][i] = 0.f;
#pragma unroll
        for (int ks = 0; ks < 6; ++ks) {
#pragma unroll
            for (int j = 0; j < 4; ++j) { const bf16x8 kf = *(const LAS bf16x8*)(Kb + j * 32 * 208 + ks * 32); s[j] = mfma32(kf, qf[ks], s[j]); }
        }
        float mx = fmaxf(fmaxf(s[0][0], s[1][0]), fmaxf(s[2][0], s[3][0]));
#pragma unroll
        for (int i = 1; i < 16; ++i) { mx = fmaxf(fmaxf(mx, s[0][i]), s[1][i]); mx = fmaxf(fmaxf(mx, s[2][i]), s[3][i]); }
        { auto rr = __builtin_amdgcn_permlane32_swap(__float_as_uint(mx), __float_as_uint(mx), false, false); mx = fmaxf(__uint_as_float(rr[0]), __uint_as_float(rr[1])); }
        if (__any(mx > m)) {
            const float mn = fmaxf(m, mx); const float alpha = __builtin_amdgcn_exp2f(m - mn); m = mn;
            lsum *= alpha;
#pragma unroll
            for (int i = 0; i < 16; ++i) { o0[i] *= alpha; o1[i] *= alpha; }
        }
        float rs0 = 0.f, rs1 = 0.f;
#pragma unroll
        for (int j = 0; j < 4; ++j)
#pragma unroll
            for (int i = 0; i < 16; i += 2) { s[j][i] = __builtin_amdgcn_exp2f(s[j][i] - m); s[j][i + 1] = __builtin_amdgcn_exp2f(s[j][i + 1] - m); rs0 += s[j][i]; rs1 += s[j][i + 1]; }
        lsum += rs0 + rs1;
        lptr Vb = lds + 2 * KT_B + b * VT_B + r * 264 + hh * 8;
#pragma unroll
        for (int j = 0; j < 4; ++j)
#pragma unroll
            for (int sh = 0; sh < 2; ++sh) {
                u32x4 w; w.x = pk2(s[j][8 * sh + 0], s[j][8 * sh + 1]); w.y = pk2(s[j][8 * sh + 2], s[j][8 * sh + 3]); w.z = pk2(s[j][8 * sh + 4], s[j][8 * sh + 5]); w.w = pk2(s[j][8 * sh + 6], s[j][8 * sh + 7]);
                const bf16x8 pb = __builtin_bit_cast(bf16x8, w);
                const int sg = 2 * j + sh;
                const s16x4 l0 = *(const LAS s16x4*)(Vb + 32 * sg), h0 = *(const LAS s16x4*)(Vb + 32 * sg + 16);
                const s16x4 l1 = *(const LAS s16x4*)(Vb + 32 * 264 + 32 * sg), h1 = *(const LAS s16x4*)(Vb + 32 * 264 + 32 * sg + 16);
                const bf16x8 v0 = __builtin_shufflevector(l0, h0, 0, 1, 2, 3, 4, 5, 6, 7), v1 = __builtin_shufflevector(l1, h1, 0, 1, 2, 3, 4, 5, 6, 7);
                o0 = mfma32(v0, pb, o0); o1 = mfma32(v1, pb, o1);
            }
        if (kt + 1 < nkt) ATT_LSTORE(b ^ 1);
        __syncthreads();
    }
#undef ATT_GLOAD
#undef ATT_LSTORE
    const float lt = add_x32(lsum); const float inv = 1.f / lt;
    bf16_t* O;
    if (part < 0) O = catp(p) + (size_t)(q_t0 + wave * 32 + r) * D + 640 + 64 * h + 4 * hh;
    else {
        O = (bf16_t*)(ws + WS_PART) + ((size_t)part * 256 + wave * 32 + r) * 64 + 4 * hh;
        if (hh == 0) { float* st = (float*)(ws + WS_PST) + ((size_t)part * 256 + wave * 32 + r) * 2; st[0] = m; st[1] = lt; }
    }
#pragma unroll
    for (int gq = 0; gq < 4; ++gq) {
        f32x4 a = {o0[4 * gq] * inv, o0[4 * gq + 1] * inv, o0[4 * gq + 2] * inv, o0[4 * gq + 3] * inv};
        f32x4 b = {o1[4 * gq] * inv, o1[4 * gq + 1] * inv, o1[4 * gq + 2] * inv, o1[4 * gq + 3] * inv};
        *(u32x2*)(O + 8 * gq) = pack4(a); *(u32x2*)(O + 32 + 8 * gq) = pack4(b);
    }
}
#endif
DI void attn_merge_item(const Params& p, int su) {
    const int tid = otid(); unsigned char* ws = p.ws;
    const int u = 256 + su, h = u >> 6, q_t0 = CTX + (u & 63) * 256;
    const bf16_t* P0 = (const bf16_t*)(ws + WS_PART) + ((size_t)su * 256) * 64; const bf16_t* P1 = P0 + (size_t)128 * 256 * 64;
    const float* S0 = (const float*)(ws + WS_PST) + ((size_t)su * 256) * 2; const float* S1 = S0 + (size_t)128 * 256 * 2;
#pragma unroll
    for (int q = 0; q < 4; ++q) {
        const int idx = tid + 512 * q, row = idx >> 3, c8 = (idx & 7) * 8;
        const float m0 = S0[row * 2], l0 = S0[row * 2 + 1], m1 = S1[row * 2], l1 = S1[row * 2 + 1];
        const float mm = fmaxf(m0, m1); const float w0 = l0 * __builtin_amdgcn_exp2f(m0 - mm), w1 = l1 * __builtin_amdgcn_exp2f(m1 - mm);
        const float iw = 1.f / (w0 + w1); const float a0 = w0 * iw, a1 = w1 * iw;
        const u32x4 x = *(const u32x4*)(P0 + (size_t)row * 64 + c8), y = *(const u32x4*)(P1 + (size_t)row * 64 + c8);
        u32x4 o;
        o.x = pk2(a0 * bflo(x.x) + a1 * bflo(y.x), a0 * bfhi(x.x) + a1 * bfhi(y.x)); o.y = pk2(a0 * bflo(x.y) + a1 * bflo(y.y), a0 * bfhi(x.y) + a1 * bfhi(y.y));
        o.z = pk2(a0 * bflo(x.z) + a1 * bflo(y.z), a0 * bfhi(x.z) + a1 * bfhi(y.z)); o.w = pk2(a0 * bflo(x.w) + a1 * bflo(y.w), a0 * bfhi(x.w) + a1 * bfhi(y.w));
        *(u32x4*)(catp(p) + (size_t)(q_t0 + row) * D + 640 + 64 * h + c8) = o;
    }
}

DI void scan_item(const Params& p, int item) {
    const int idx = item * NTHREADS + otid();
    const int dir = idx / 12288, rem = idx % 12288, h = rem >> 11, de = rem & 2047, d = de >> 6, e = de & 63;
    const float* DS = (const float*)(p.ws + WS_DS) + (size_t)dir * NCH * 6 * 2048;
    float* SST = (float*)(p.ws + WS_SST) + (size_t)dir * NCH * 6 * 2048;
    const float g128 = exp2f(128.f * log2f(gamma_f(dir ? 5 - h : h)));
    float S = 0.f;
    for (int i0 = 0; i0 < NCH; i0 += 10) {
        float dv[10]; int cc[10];
#pragma unroll
        for (int u = 0; u < 10; ++u) {
            const int i = i0 + u;
            const int c = dir ? (i < 2 ? 1 - i : NCH + 1 - i) : i;
            cc[u] = c; dv[u] = DS[((size_t)c * 6 + h) * 2048 + de];
        }
#pragma unroll
        for (int u = 0; u < 10; ++u) {
            SST[((size_t)cc[u] * 6 + h) * 2048 + de] = S;
            S = S * g128 + dv[u];
        }
    }
}

DI void phase_pd(const Params& p, lptr lds, int l) {
    const int bid = obid(), G = gridDim.x;
    const int njobs = (l == DEPTH - 1) ? 512 : 518;
#pragma unroll 1
    for (int job = bid; job < njobs; job += G) {
        int h, q_t0, kt0 = 0, nkt = T / 128, part = -1;
        if (job < 256) { h = job >> 6; q_t0 = CTX + (job & 63) * 256; }
        else if (job < 512) { const int su = (job - 256) >> 1, half = job & 1, u = 256 + su; h = u >> 6; q_t0 = CTX + (u & 63) * 256; kt0 = half * (T / 256); nkt = T / 256; part = half * 128 + su; }
        else { h = job - 512; q_t0 = 0; nkt = CTX / 128; }
        attn_unit(p, lds, h, q_t0, kt0, nkt, part);
    }
#pragma unroll 1
    for (int it = (bid + G - (8 % G)) % G; it < 48; it += G) scan_item(p, it);
}

struct RetRaw { u32x4 q, k; u32x2 va[2], vb[2]; f32x4 s0, s1; };
DI void retout_load(const Params& p, int c, int h, RetRaw& r) {
    const int tid = otid(); unsigned char* ws = p.ws;
    const bf16_t* RQ = (const bf16_t*)(ws + WS_RQ); const bf16_t* RK = (const bf16_t*)(ws + WS_RK); const bf16_t* RV = (const bf16_t*)(ws + WS_RV);
    const float* SST = (const float*)(ws + WS_SST);
    const int t0 = c * 128;
    { const int row = tid >> 2, ch = tid & 3;
      r.q = *(const u32x4*)(RQ + (size_t)(t0 + row) * 192 + h * 32 + ch * 8); r.k = *(const u32x4*)(RK + (size_t)(t0 + row) * 192 + h * 32 + ch * 8); }
#pragma unroll
    for (int q = 0; q < 2; ++q) {
        const int idx = tid + 512 * q, rp = idx >> 4, c4 = (idx & 15) * 4;
        r.va[q] = *(const u32x2*)(RV + (size_t)(t0 + 2 * rp) * 384 + h * 64 + c4); r.vb[q] = *(const u32x2*)(RV + (size_t)(t0 + 2 * rp + 1) * 384 + h * 64 + c4);
    }
    { const int dir = tid >> 8, tt = tid & 255, dp = tt >> 4, e4 = (tt & 15) * 4;
      const float* S = SST + (((size_t)dir * NCH + c) * 6 + h) * 2048;
      r.s0 = *(const f32x4*)(S + (2 * dp) * 64 + e4); r.s1 = *(const f32x4*)(S + (2 * dp + 1) * 64 + e4); }
}
DI void retout_item(const Params& p, lptr lds, int c, int h, RetRaw& raw, bool has_next, int cn, int hn) {
    const int tid = otid(), lane = tid & 63, wave = tid >> 6, il = lane & 15, g = lane >> 4;
    unsigned char* ws = p.ws;
    constexpr int OQ = 0, OK_ = 10240, OV = 20480, OSF = 37376, OSB = 42496;
    const int t0 = c * 128;
    __syncthreads();
    {
        const int row = tid >> 2, ch = tid & 3;
        *(LAS u32x4*)(lds + OQ + row * 80 + ch * 16) = raw.q;
        *(LAS u32x4*)(lds + OK_ + row * 80 + ch * 16) = raw.k;
    }
#pragma unroll
    for (int q = 0; q < 2; ++q) {
        const int idx = tid + 512 * q, rp = idx >> 4, c4 = (idx & 15) * 4;
        const u32x2 a = raw.va[q], b = raw.vb[q];
        *(LAS unsigned*)(lds + OV + (c4 + 0) * 264 + rp * 4) = (a.x & 0xffffu) | (b.x << 16);
        *(LAS unsigned*)(lds + OV + (c4 + 1) * 264 + rp * 4) = (a.x >> 16) | (b.x & 0xffff0000u);
        *(LAS unsigned*)(lds + OV + (c4 + 2) * 264 + rp * 4) = (a.y & 0xffffu) | (b.y << 16);
        *(LAS unsigned*)(lds + OV + (c4 + 3) * 264 + rp * 4) = (a.y >> 16) | (b.y & 0xffff0000u);
    }
    {
        const int dir = tid >> 8, tt = tid & 255, dp = tt >> 4, e4 = (tt & 15) * 4;
        const f32x4 v0 = raw.s0, v1 = raw.s1;
#pragma unroll
        for (int i = 0; i < 4; ++i) *(LAS unsigned*)(lds + (dir ? OSB : OSF) + (e4 + i) * 80 + dp * 4) = pk2(v0[i], v1[i]);
    }
    __syncthreads();
    if (has_next) retout_load(p, cn, hn, raw);
    const int i = 16 * wave + il;
    const f32x4 zero = {0.f, 0.f, 0.f, 0.f};
    const bf16x8 qf = *(const LAS bf16x8*)(lds + OQ + i * 80 + g * 16);
    f32x4 A[8];
#pragma unroll
    for (int jt = 0; jt < 8; ++jt) { const bf16x8 kf = *(const LAS bf16x8*)(lds + OK_ + (16 * jt + il) * 80 + g * 16); A[jt] = mfma16(kf, qf, zero); }
    asm volatile("s_nop 15\n\ts_nop 15" : "+v"(A[0]), "+v"(A[1]), "+v"(A[2]), "+v"(A[3]), "+v"(A[4]), "+v"(A[5]), "+v"(A[6]), "+v"(A[7]));
    const float lgf = log2f(gamma_f(h)), lgb = log2f(gamma_f(5 - h));
    bf16x8 pf[4], pbk[4];
#pragma unroll
    for (int s = 0; s < 4; ++s) {
        u32x4 wf, wb; float vf[8], vb[8];
#pragma unroll
        for (int hf = 0; hf < 2; ++hf)
#pragma unroll
            for (int r = 0; r < 4; ++r) {
                const int jt = 2 * s + hf, j = 16 * jt + 4 * g + r; const float a = A[jt][r];
                vf[hf * 4 + r] = (j <= i) ? a * exp2f((float)(i - j) * lgf) : 0.f;
                vb[hf * 4 + r] = (j >= i) ? a * exp2f((float)(j - i) * lgb) : 0.f;
            }
        wf.x = pk2(vf[0], vf[1]); wf.y = pk2(vf[2], vf[3]); wf.z = pk2(vf[4], vf[5]); wf.w = pk2(vf[6], vf[7]);
        wb.x = pk2(vb[0], vb[1]); wb.y = pk2(vb[2], vb[3]); wb.z = pk2(vb[4], vb[5]); wb.w = pk2(vb[6], vb[7]);
        pf[s] = __builtin_bit_cast(bf16x8, wf); pbk[s] = __builtin_bit_cast(bf16x8, wb);
    }
    const float xf = exp2f((float)(i + 1) * lgf), xb = exp2f((float)(128 - i) * lgb);
    bf16x8 qff, qfb;
    {
        const u32x4 qr = __builtin_bit_cast(u32x4, qf); u32x4 a, b;
        a.x = pk2(bflo(qr.x) * xf, bfhi(qr.x) * xf); a.y = pk2(bflo(qr.y) * xf, bfhi(qr.y) * xf); a.z = pk2(bflo(qr.z) * xf, bfhi(qr.z) * xf); a.w = pk2(bflo(qr.w) * xf, bfhi(qr.w) * xf);
        b.x = pk2(bflo(qr.x) * xb, bfhi(qr.x) * xb); b.y = pk2(bflo(qr.y) * xb, bfhi(qr.y) * xb); b.z = pk2(bflo(qr.z) * xb, bfhi(qr.z) * xb); b.w = pk2(bflo(qr.w) * xb, bfhi(qr.w) * xb);
        qff = __builtin_bit_cast(bf16x8, a); qfb = __builtin_bit_cast(bf16x8, b);
    }
    f32x4 of[4], ob[4];
#pragma unroll
    for (int et = 0; et < 4; ++et) {
        const bf16x8 sf = *(const LAS bf16x8*)(lds + OSF + (16 * et + il) * 80 + g * 16), sb = *(const LAS bf16x8*)(lds + OSB + (16 * et + il) * 80 + g * 16);
        of[et] = mfma16(sf, qff, zero); ob[et] = mfma16(sb, qfb, zero);
#pragma unroll
        for (int s = 0; s < 4; ++s) {
            const s16x4 lo = *(const LAS s16x4*)(lds + OV + (16 * et + il) * 264 + (32 * s + 4 * g) * 2), hi = *(const LAS s16x4*)(lds + OV + (16 * et + il) * 264 + (32 * s + 16 + 4 * g) * 2);
            const bf16x8 vfr = __builtin_shufflevector(lo, hi, 0, 1, 2, 3, 4, 5, 6, 7);
            of[et] = mfma16(vfr, pf[s], of[et]); ob[et] = mfma16(vfr, pbk[s], ob[et]);
        }
    }
    asm volatile("s_nop 15\n\ts_nop 15" : "+v"(of[0]), "+v"(of[1]), "+v"(of[2]), "+v"(of[3]), "+v"(ob[0]), "+v"(ob[1]), "+v"(ob[2]), "+v"(ob[3]));
    float sf_ = 0.f, sb_ = 0.f;
#pragma unroll
    for (int et = 0; et < 4; ++et) { sf_ += (of[et][0] + of[et][1]) + (of[et][2] + of[et][3]); sb_ += (ob[et][0] + ob[et][1]) + (ob[et][2] + ob[et][3]); }
    sf_ = sum_16_32(sf_); sb_ = sum_16_32(sb_);
    const float muf = sf_ * (1.f / 64.f), mub = sb_ * (1.f / 64.f);
    float qf_ = 0.f, qb_ = 0.f;
#pragma unroll
    for (int et = 0; et < 4; ++et)
#pragma unroll
        for (int r = 0; r < 4; ++r) { const float a = of[et][r] - muf, b = ob[et][r] - mub; qf_ += a * a; qb_ += b * b; }
    qf_ = sum_16_32(qf_); qb_ = sum_16_32(qb_);
    const float rf = 1.f / sqrtf(qf_ * (1.f / 64.f) + 1e-5f), rb = 1.f / sqrtf(qb_ * (1.f / 64.f) + 1e-5f);
    const int t = t0 + i;
    const bf16_t* GF = (const bf16_t*)(ws + WS_GF) + (size_t)t * 384 + 64 * h + 4 * g; const bf16_t* GB = (const bf16_t*)(ws + WS_GB) + (size_t)t * 384 + 64 * h + 4 * g;
    bf16_t* O = catp(p) + (size_t)t * D + 256 + 64 * h + 4 * g;
#pragma unroll
    for (int et = 0; et < 4; ++et) {
        const u32x2 a = *(const u32x2*)(GF + 16 * et), b = *(const u32x2*)(GB + 16 * et);
        f32x4 o;
        o[0] = bflo(a.x) * (of[et][0] - muf) * rf + bflo(b.x) * (ob[et][0] - mub) * rb;
        o[1] = bfhi(a.x) * (of[et][1] - muf) * rf + bfhi(b.x) * (ob[et][1] - mub) * rb;
        o[2] = bflo(a.y) * (of[et][2] - muf) * rf + bflo(b.y) * (ob[et][2] - mub) * rb;
        o[3] = bfhi(a.y) * (of[et][3] - muf) * rf + bfhi(b.y) * (ob[et][3] - mub) * rb;
        *(u32x2*)(O + 16 * et) = pack4(o);
    }
}
DI void phase_pe(const Params& p, lptr lds, int l) {
    const int G = gridDim.x;
    const int skip = (l == DEPTH - 1) ? (CTX / 128) * 6 : 0, NRET = NCH * 6 - skip;
    RetRaw raw;
    int it = obid();
    if (it < NRET) retout_load(p, (it + skip) / 6, (it + skip) % 6, raw);
#pragma unroll 1
    for (; it < NRET + 128; it += G) {
        if (it < NRET) { const int nx = it + G; const bool hn = nx < NRET; retout_item(p, lds, (it + skip) / 6, (it + skip) % 6, raw, hn, hn ? (nx + skip) / 6 : 0, hn ? (nx + skip) % 6 : 0); }
        else attn_merge_item(p, it - NRET);
    }
}

template <int BM, int WMv, int WNv>
DI void outproj_tile(const Params& p, lptr lds, int l, int m0, int n0) {
    typedef GemmTile<BM, 128, WMv, WNv, false> G;
    constexpr int MI = G::MI, NI = G::NI;
    const int tid = otid(), lane = tid & 63, wave = tid >> 6, wm = wave / WNv, wn = wave % WNv, il = lane & 15, g = lane >> 4;
    unsigned char* ws = p.ws;
    const bf16_t* CAT = catp(p); const bf16_t* W = (const bf16_t*)(ws + WS_WOUT) + (size_t)l * D * D;
    f32x4 acc[MI][NI]; zero_acc(acc);
    const bf16_t* arow[G::AP];
#pragma unroll
    for (int q = 0; q < G::AP; ++q) arow[q] = CAT + (size_t)(m0 + (tid >> 3) + 64 * q) * D + (tid & 7) * 8;
    G::run(acc, lds, arow, lds, W + (size_t)n0 * D, D, D);
    const int v = (m0 < CTX) ? 1 : 0;
    const float* g1 = modp(p, l, v, 2);
#pragma unroll
    for (int mi = 0; mi < MI; ++mi) {
        const int t = m0 + wm * (BM / WMv) + mi * 16 + il;
        if (t < CTX) {
            float* dst = (float*)(ws + WS_XC) + (size_t)t * D; const float* src = (l == 0) ? p.ctx + (size_t)t * D : dst;
#pragma unroll
            for (int ni = 0; ni < NI; ++ni) {
                const int col = n0 + wn * (128 / WNv) + 16 * ni + 4 * g;
                const f32x4 r = *(const f32x4*)(src + col), gg = *(const f32x4*)(g1 + col);
                *(f32x4*)(dst + col) = r + gg * acc[mi][ni];
            }
        } else {
            bf16_t* dst = xbp(p) + (size_t)(t - CTX) * D;
#pragma unroll
            for (int ni = 0; ni < NI; ++ni) {
                const int col = n0 + wn * (128 / WNv) + 16 * ni + 4 * g;
                const f32x4 r = (l == 0) ? *(const f32x4*)(p.x + (size_t)(t - CTX) * D + col) : ld4bf(dst + col), gg = *(const f32x4*)(g1 + col);
                *(u32x2*)(dst + col) = pack4(r + gg * acc[mi][ni]);
            }
        }
    }
}
struct EpiOutproj {
    static constexpr bool PERM = false, AFTER_DRAIN = false;
    const float* src32; bf16_t* xb; const float* g1;
    DI void operator()(const f32x4 (&acc)[2][2][4][2], const pg8::Unit& u, int wr, int wc, int fr, int fq) const {
#pragma unroll
        for (int ai = 0; ai < 2; ++ai)
#pragma unroll
            for (int m = 0; m < 4; ++m) {
                const size_t ro = (size_t)(u.pm * 256 + ai * 128 + wr * 64 + m * 16 + fr) * D;
#pragma unroll
                for (int bj = 0; bj < 2; ++bj)
#pragma unroll
                    for (int n = 0; n < 2; ++n) {
                        const int col = u.pn * 256 + bj * 128 + wc * 32 + 16 * n + 4 * fq;
                        const f32x4 r = src32 ? *(const f32x4*)(src32 + ro + col) : ld4bf(xb + ro + col), gg = *(const f32x4*)(g1 + col);
                        *(u32x2*)(xb + ro + col) = pack4(r + gg * acc[ai][bj][m][n]);
                    }
            }
    }
};
DI void phase_outproj(const Params& p, lptr lds, int l) {
    {
        pg8::Gemm g{catp(p) + (size_t)CTX * D, (const bf16_t*)(p.ws + WS_WOUT) + (size_t)l * D * D, SEQ, D, D};
        pg8::StaticOrder S; S.init(SEQ, D, (int)gridDim.x, obid());
        EpiOutproj E{(l == 0) ? p.x : nullptr, xbp(p), modp(p, l, 0, 2)};
        pg8::gemm_phase<EpiOutproj, pg8::StaticOrder, false, PG8_SP2>(lds, g, S, E);
    }
    if (l != DEPTH - 1) {
        for (int c = obid(); c < 32; c += gridDim.x) outproj_tile<64, 1, 8>(p, lds, l, (c >> 3) * 64, (c & 7) * 128);
    }
}

DI void phase_router(const Params& p, lptr lds, int l, int dummy = 0) {
    const int tid = otid(), lane = tid & 63, wave = tid >> 6, il = lane & 15, g = lane >> 4; unsigned char* ws = p.ws;
    constexpr int RWS = 2064;
    constexpr int O_RWH = 0, O_RWL = 16 * RWS, O_WC = 2 * 16 * RWS, O_SH = O_WC + 2 * 1024 * 4, O_CNT = O_SH + 2 * 1024 * 4;
    __syncthreads();
    {
#pragma unroll
        for (int j = 0; j < 4; ++j) {
            const int it = tid + 512 * j, kp = it >> 2, e0 = (it & 3) * 4;
            const f32x4 va = *(const f32x4*)(p.router_w + (size_t)(2 * kp) * 16 + e0), vb = *(const f32x4*)(p.router_w + (size_t)(2 * kp + 1) * 16 + e0);
#pragma unroll
            for (int q = 0; q < 4; ++q) {
                const unsigned ha = f2bf(va[q]), hb = f2bf(vb[q]);
                const float la = va[q] - __uint_as_float(ha << 16), lb = vb[q] - __uint_as_float(hb << 16);
                *(LAS unsigned*)(lds + O_RWH + (e0 + q) * RWS + kp * 4) = ha | (hb << 16);
                *(LAS unsigned*)(lds + O_RWL + (e0 + q) * RWS + kp * 4) = pk2(la, lb);
            }
        }
        const float* nw = p.norm2_w + l * D;
#pragma unroll
        for (int j = 0; j < 4; ++j) { const int i = tid + 512 * j, v = i >> 10, k = i & 1023;
            *(LAS float*)(lds + O_WC + i * 4) = nw[k] * (1.f + modp(p, l, v, 4)[k]); *(LAS float*)(lds + O_SH + i * 4) = modp(p, l, v, 3)[k]; }
        if (tid < 16) *(LAS int*)(lds + O_CNT + tid * 4) = 0;
    }
    __syncthreads();
    if (l == DEPTH - 2 && defer_moe_weights() && __builtin_amdgcn_readfirstlane(wave) >= 5) {
        const int w5 = __builtin_amdgcn_readfirstlane(wave) - 5;
        LAS unsigned* scr = (LAS unsigned*)(lds + 90112 + w5 * 8448);
#pragma unroll 1
        for (int it = w5 * (int)gridDim.x + obid(); it < I_MOE; it += 3 * (int)gridDim.x) weight_item(p, scr, DEPTH - 1, I_SMALL + it, lane);
    }
    int* CNT = (int*)(ws + WS_CNT) + (l + 2 * dummy) * 1024; int* LIST = (int*)(ws + (dummy ? WS_PART : WS_LIST)); float* GW = (float*)(ws + (dummy ? WS_PART + (2u << 20) : WS_GW));
    const int g_lo = (l == DEPTH - 1) ? CTX / 16 : 0, ngroups = T / 16 - g_lo;
    const int gi = obid() + (int)gridDim.x * wave;
    int se0 = 0, se1 = 0, stok = -1, q0 = 0, q1 = 0; float sw0 = 0.f, sw1 = 0.f;
    if (gi < ngroups) {
        const int t = (g_lo + gi) * 16 + il; const bool isctx = t < CTX; const int v = isctx ? 1 : 0;
        const float* X = (const float*)(ws + WS_XC) + (size_t)(isctx ? t : 0) * D + 8 * g;
        const bf16_t* XB = xbp(p) + (size_t)(isctx ? 0 : t - CTX) * D + 8 * g;
        bf16_t* H = (dummy ? catp(p) : (bf16_t*)(ws + WS_H2)) + (size_t)t * D + 8 * g;
        f32x4 acc = zacc4();
        lptr wcp = lds + O_WC + (v * 1024 + 8 * g) * 4; lptr shp = lds + O_SH + (v * 1024 + 8 * g) * 4;
        lptr rwh = lds + O_RWH + il * RWS + 16 * g; lptr rwl = lds + O_RWL + il * RWS + 16 * g;
        auto sq8 = [](const f32x4 a, const f32x4 b) __attribute__((always_inline)) { return (a[0] * a[0] + a[1] * a[1]) + (a[2] * a[2] + a[3] * a[3]) + (b[0] * b[0] + b[1] * b[1]) + (b[2] * b[2] + b[3] * b[3]); };
        auto step = [&](const int s32, const f32x4 a, const f32x4 b, const float rstd) __attribute__((always_inline)) {
            const f32x4 wa = *(const LAS f32x4*)(wcp + 128 * s32), wb = *(const LAS f32x4*)(wcp + 128 * s32 + 16), sa = *(const LAS f32x4*)(shp + 128 * s32), sb = *(const LAS f32x4*)(shp + 128 * s32 + 16);
            const f32x4 ha = a * rstd * wa + sa, hb = b * rstd * wb + sb;
            u32x4 hi; hi.x = pk2(ha[0], ha[1]); hi.y = pk2(ha[2], ha[3]); hi.z = pk2(hb[0], hb[1]); hi.w = pk2(hb[2], hb[3]);
            *(u32x4*)(H + 32 * s32) = hi;
            u32x4 lo; lo.x = pk2(ha[0] - bflo(hi.x), ha[1] - bfhi(hi.x)); lo.y = pk2(ha[2] - bflo(hi.y), ha[3] - bfhi(hi.y)); lo.z = pk2(hb[0] - bflo(hi.z), hb[1] - bfhi(hi.z)); lo.w = pk2(hb[2] - bflo(hi.w), hb[3] - bfhi(hi.w));
            const bf16x8 fh = *(const LAS bf16x8*)(rwh + 64 * s32), fl = *(const LAS bf16x8*)(rwl + 64 * s32);
            const bf16x8 bh = __builtin_bit_cast(bf16x8, hi), bl = __builtin_bit_cast(bf16x8, lo);
            acc = mfma16(fh, bh, acc); acc = mfma16(fh, bl, acc); acc = mfma16(fl, bh, acc);
        };
        if (isctx) {
            float ss = 0.f;
#pragma unroll 16
            for (int s32 = 0; s32 < 32; ++s32) ss += sq8(*(const f32x4*)(X + 32 * s32), *(const f32x4*)(X + 32 * s32 + 4));
            ss = sum_16_32(ss);
            const float rstd = 1.f / sqrtf(ss * (1.f / D) + 1e-6f);
#pragma unroll 8
            for (int s32 = 0; s32 < 32; ++s32) step(s32, *(const f32x4*)(X + 32 * s32), *(const f32x4*)(X + 32 * s32 + 4), rstd);
        } else {
            u32x4 xr[32];
            asm volatile("" : "+v"(XB), "+v"(H));
#pragma unroll
            for (int s32 = 0; s32 < 32; ++s32) xr[s32] = *(const u32x4*)(XB + 32 * s32);
            float ss = 0.f;
#pragma unroll
            for (int s32 = 0; s32 < 32; ++s32) ss += sq8(unpack4((u32x2){xr[s32].x, xr[s32].y}), unpack4((u32x2){xr[s32].z, xr[s32].w}));
            ss = sum_16_32(ss);
            const float rstd = 1.f / sqrtf(ss * (1.f / D) + 1e-6f);
#pragma unroll
            for (int s32 = 0; s32 < 32; ++s32) asm volatile("" : "+v"(xr[s32]));
#pragma unroll
            for (int s32 = 0; s32 < 32; ++s32) { step(s32, unpack4((u32x2){xr[s32].x, xr[s32].y}), unpack4((u32x2){xr[s32].z, xr[s32].w}), rstd); if ((s32 & 3) == 3) __builtin_amdgcn_sched_barrier(0); }
        }
        float aff[4], sel[4];
#pragma unroll
        for (int r = 0; r < 4; ++r) { aff[r] = __builtin_amdgcn_rcpf(1.f + __expf(-acc[r])); sel[r] = aff[r] + p.router_bias[4 * g + r]; }
        const float lo_ab = fminf(sel[0], sel[1]), hi_ab = fmaxf(sel[0], sel[1]), lo_cd = fminf(sel[2], sel[3]), hi_cd = fmaxf(sel[2], sel[3]);
        const float gs = fmaxf(hi_ab, hi_cd) + fmaxf(fminf(hi_ab, hi_cd), fmaxf(lo_ab, lo_cd));
        const int gsi = __float_as_int(gs);
        const float g0 = __int_as_float(__builtin_amdgcn_ds_bpermute(il << 2, gsi)), g1 = __int_as_float(__builtin_amdgcn_ds_bpermute((16 + il) << 2, gsi)),
                    g2 = __int_as_float(__builtin_amdgcn_ds_bpermute((32 + il) << 2, gsi)), g3 = __int_as_float(__builtin_amdgcn_ds_bpermute((48 + il) << 2, gsi));
        int best = 0; float bv = g0;
        if (g1 > bv) { bv = g1; best = 1; }
        if (g2 > bv) { bv = g2; best = 2; }
        if (g3 > bv) { bv = g3; best = 3; }
        if (g == best) {
            int i0 = 0; float v0 = sel[0], w0 = aff[0];
#pragma unroll
            for (int k = 1; k < 4; ++k) if (sel[k] > v0) { v0 = sel[k]; w0 = aff[k]; i0 = k; }
            int i1 = -1; float v1 = -1e30f, w1 = 0.f;
#pragma unroll
            for (int k = 0; k < 4; ++k) if (k != i0 && (i1 < 0 || sel[k] > v1)) { v1 = sel[k]; w1 = aff[k]; i1 = k; }
            const float wsum = w0 + w1;
            se0 = 4 * g + i0; se1 = 4 * g + i1; sw0 = w0 / wsum; sw1 = w1 / wsum; stok = t;
            q0 = __hip_atomic_fetch_add((LAS int*)(lds + O_CNT) + se0, 1, __ATOMIC_RELAXED, __HIP_MEMORY_SCOPE_WORKGROUP);
            q1 = __hip_atomic_fetch_add((LAS int*)(lds + O_CNT) + se1, 1, __ATOMIC_RELAXED, __HIP_MEMORY_SCOPE_WORKGROUP);
        }
    }
    LAS int* lcnt = (LAS int*)(lds + O_CNT); LAS int* lbase = lcnt + 16;
    __syncthreads();
    if (tid < 16) lbase[tid] = atomicAdd(&CNT[tid * 64], lcnt[tid]);
    __syncthreads();
    if (stok >= 0) {
        const int p0 = lbase[se0] + q0, p1 = lbase[se1] + q1;
        LIST[(size_t)se0 * T + p0] = 2 * stok; GW[2 * stok] = sw0;
        LIST[(size_t)se1 * T + p1] = 2 * stok + 1; GW[2 * stok + 1] = sw1;
    }
}

constexpr int MOE_BM = 144, MOE_PF = 3;
DI void moe_item(const Params& p, lptr lds, int l, int e, int r0, int nr) {
    typedef GemmTile<MOE_BM, 256, 1, 8, false, MOE_PF> G1; typedef GemmTile<MOE_BM, 256, 1, 8, true, 4> G2;
    const int tid = otid(), lane = tid & 63, wave = tid >> 6, wn = wave, il = lane & 15, g = lane >> 4;
    unsigned char* ws = p.ws;
    LAS int* rowent = (LAS int*)lds; LAS float* roww = (LAS float*)(lds + 1024);
    lptr stage = lds + 2048; lptr HE = lds + 2048 + (MOE_BM * 128 + 256 * 128);
    const int* LIST = (const int*)(ws + WS_LIST) + (size_t)e * T; const float* GW = (const float*)(ws + WS_GW);
    __syncthreads();
    if (tid < MOE_BM) { const int ent = tid < nr ? LIST[r0 + tid] : -1; rowent[tid] = ent; roww[tid] = ent >= 0 ? GW[ent] : 0.f; }
    __syncthreads();
    const bf16_t* H2 = (const bf16_t*)(ws + WS_H2);
    const bf16_t* arow[3];
#pragma unroll
    for (int q = 0; q < 3; ++q) { const int rr = (tid >> 3) + 64 * q; const int ent = rr < MOE_BM ? rowent[rr] : -1; const int tok = ent >= 0 ? (ent >> 1) : 0; arow[q] = H2 + (size_t)tok * D + (tid & 7) * 8; }
    const bf16_t* WGU = (const bf16_t*)(ws + WS_WGU) + ((size_t)l * 16 + e) * 512 * 1024;
    const bf16_t* WDN = (const bf16_t*)(ws + WS_WDN) + ((size_t)l * 16 + e) * 1024 * 256;
    f32x4 acc[9][2]; zero_acc(acc);
    G1::run_panels(acc, stage, arow, stage, WGU, 1024, 1024, 2, (size_t)256 * 1024, [&](const int nt2, f32x4 (&a_)[9][2]) __attribute__((always_inline)) {
        const int chn = 128 * nt2 + 16 * wn + 4 * g;
        const int panel = chn >> 6, cc = chn & 63;
#pragma unroll
        for (int mi = 0; mi < 9; ++mi) {
            const int r = 16 * mi + il;
            const f32x4 a = a_[mi][0], b = a_[mi][1];
            f32x4 o;
#pragma unroll
            for (int j = 0; j < 4; ++j) o[j] = fsilu(a[j]) * b[j];
            *(LAS u32x2*)(HE + panel * (MOE_BM * 128) + swz_off(r, cc >> 3) + (cc & 4) * 2) = pack4(o);
        }
    });
    __syncthreads();
    bf16_t* Y = (bf16_t*)(ws + WS_Y);
    const bf16_t* dummy[3] = {nullptr, nullptr, nullptr};
    G2::run_panels(acc, stage, dummy, HE, WDN, 256, 256, 4, (size_t)256 * 256, [&](const int nt, f32x4 (&a_)[9][2]) __attribute__((always_inline)) {
#pragma unroll
        for (int mi = 0; mi < 9; ++mi) {
            const int r = 16 * mi + il; const int ent = rowent[r]; const float w = roww[r];
            if (ent >= 0) {
#pragma unroll
                for (int ni = 0; ni < 2; ++ni) *(u32x2*)(Y + (size_t)ent * D + nt * 256 + wn * 32 + 16 * ni + 4 * g) = pack4(a_[mi][ni] * w);
            }
        }
    });
}
DI void phase_moe(const Params& p, lptr lds, int l) {
    int* CNT = (int*)(p.ws + WS_CNT) + l * 1024;
    LAS int* lc = (LAS int*)(lds + 256);
    __syncthreads();
    if (otid() < 16) lc[otid()] = __hip_atomic_fetch_add(&CNT[otid() * 64], 0, __ATOMIC_RELAXED, __HIP_MEMORY_SCOPE_AGENT);
    __syncthreads();
    int cnt[16], total = 0;
#pragma unroll
    for (int e = 0; e < 16; ++e) { cnt[e] = __builtin_amdgcn_readfirstlane(lc[e]); total += (cnt[e] + MOE_BM - 1) / MOE_BM; }
    __syncthreads();
    for (int it = obid(); it < total; it += gridDim.x) {
        int base = 0, fe = 0, fm = 0, fc = 0, fn = 1;
#pragma unroll
        for (int e = 0; e < 16; ++e) { const int n = (cnt[e] + MOE_BM - 1) / MOE_BM; if (it >= base && it < base + n) { fe = e; fm = it - base; fc = cnt[e]; fn = n; } base += n; }
        const int rpi = (fc + fn - 1) / fn;
        const int r0 = fm * rpi; const int nr = (fc - r0 < rpi) ? (fc - r0) : rpi;
        moe_item(p, lds, l, fe, r0, nr);
    }
}

DI void phase_final(const Params& p) {
    const int tid_ = otid(); const int lane = tid_ & 63, wave = tid_ >> 6;
    const int gw = obid() * NWAVES + wave, NGW = gridDim.x * NWAVES;
    const float* g2 = modp(p, DEPTH - 1, 0, 5);
    struct Raw { u32x2 xb[4], ya[4], yb[4]; };
    auto load_raw = [&](const int t, Raw& r) __attribute__((always_inline)) {
        const bf16_t* XB = xbp(p) + (size_t)(t - CTX) * D; const bf16_t* Y0 = (const bf16_t*)(p.ws + WS_Y) + (size_t)(2 * t) * D;
#pragma unroll
        for (int j = 0; j < 4; ++j) { const int o = 4 * lane + 256 * j; r.xb[j] = *(const u32x2*)(XB + o); r.ya[j] = *(const u32x2*)(Y0 + o); r.yb[j] = *(const u32x2*)(Y0 + D + o); }
    };
    auto process = [&](const int t, Raw& r) __attribute__((always_inline)) {
        float* X = p.out + (size_t)(t - CTX) * D;
        f32x4 xv[4]; float ss = 0.f;
#pragma unroll
        for (int j = 0; j < 4; ++j) {
            const int o = 4 * lane + 256 * j;
            f32x4 xx = unpack4(r.xb[j]);
            const u32x2 a = r.ya[j], b = r.yb[j];
            const f32x4 g = *(const f32x4*)(g2 + o);
            xx[0] += g[0] * (bflo(a.x) + bflo(b.x)); xx[1] += g[1] * (bfhi(a.x) + bfhi(b.x));
            xx[2] += g[2] * (bflo(a.y) + bflo(b.y)); xx[3] += g[3] * (bfhi(a.y) + bfhi(b.y));
            xv[j] = xx; ss += (xx[0] * xx[0] + xx[1] * xx[1]) + (xx[2] * xx[2] + xx[3] * xx[3]);
        }
        const float rstd = 1.f / sqrtf(wave_sum(ss) * (1.f / D) + 1e-6f);
#pragma unroll
        for (int j = 0; j < 4; ++j) {
            const int o = 4 * lane + 256 * j; const f32x4 w = *(const f32x4*)(p.final_w + o);
            *(f32x4*)(X + o) = xv[j] * rstd * w;
        }
    };
#pragma unroll 1
    for (int t = CTX + gw; t < T; t += 2 * NGW) {
        Raw r0, r1; const int t1 = t + NGW; const bool has1 = t1 < T;
        load_raw(t, r0); if (has1) load_raw(t1, r1);
        process(t, r0); if (has1) process(t1, r1);
    }
}


#define XB_TMO      128
#define XB_XCNT(j)  (256  + 64 * (j))
#define XB_XSUB(j)  (1280 + 64 * (j))
#define XB_XGEN(j)  (2304 + 64 * (j))
#define XB_TOP      3328
#define XB_TOPGEN   3392
#define XCD_BAR_WORDS 3456
#define XB_SPIN_CAP (1u << 20)
DI unsigned xb_ld(unsigned* p)              { return __hip_atomic_load(p, __ATOMIC_RELAXED, __HIP_MEMORY_SCOPE_AGENT); }
DI unsigned xb_add(unsigned* p, unsigned v) { return __hip_atomic_fetch_add(p, v, __ATOMIC_RELAXED, __HIP_MEMORY_SCOPE_AGENT); }
DI unsigned xb_xcc_id() { return (unsigned)__builtin_amdgcn_s_getreg((3 << 11) | 20) & 0xFu; }
#define XB_SPIN(cond, bar) do { unsigned _sp = 0; while (cond) { __builtin_amdgcn_s_sleep(1); \
    if ((++_sp & 255u) == 0u) { if (xb_ld(&(bar)[XB_TMO])) break; if (_sp > XB_SPIN_CAP) { atomicAdd(&(bar)[XB_TMO], 1u); break; } } } } while (0)
struct XcdBarrier { unsigned* bar; unsigned x; volatile LAS unsigned* st; };
DI XcdBarrier xcd_barrier_post(unsigned* bar, volatile LAS unsigned* st) {
    XcdBarrier b; b.bar = bar; b.x = xb_xcc_id(); b.st = st;
    if (threadIdx.x == 0) (void)xb_add(&bar[XB_XCNT(b.x)], 1u);
    return b;
}
DI void xcd_barrier_complete(unsigned* bar, unsigned x, unsigned& nloc, unsigned& nx) {
    const unsigned G = gridDim.x * gridDim.y * gridDim.z;
    unsigned sum, cnt, mine, sp = 0u;
    for (;;) {
        sum = 0u; cnt = 0u; mine = 0u;
#pragma unroll
        for (unsigned j = 0; j < 16; ++j) { const unsigned c = xb_ld(&bar[XB_XCNT(j)]); sum += c; cnt += (c > 0u) ? 1u : 0u; mine = (j == x) ? c : mine; }
        if (sum == G) break;
        __builtin_amdgcn_s_sleep(1);
        if ((++sp & 255u) == 0u) { if (xb_ld(&bar[XB_TMO])) break; if (sp > XB_SPIN_CAP) { atomicAdd(&bar[XB_TMO], 1u); break; } }
    }
    nloc = mine > 0u ? mine : 1u; nx = cnt > 0u ? cnt : 1u;
}
DI void xcd_barrier(const XcdBarrier& b) {
    asm volatile("s_waitcnt vmcnt(0)" ::: "memory");
    __syncthreads();
    if (threadIdx.x == 0) {
        unsigned* bar = b.bar;
        __builtin_amdgcn_s_waitcnt(0);
        unsigned nloc = b.st[0], nx = b.st[1];
        if (nloc == 0u) { xcd_barrier_complete(bar, b.x, nloc, nx); b.st[0] = nloc; b.st[1] = nx; }
        const unsigned old = xb_add(&bar[XB_XSUB(b.x)], 1u);
        const unsigned gen = old / nloc;
        if (old + 1u == (gen + 1u) * nloc) {
            __builtin_amdgcn_fence(__ATOMIC_RELEASE, "agent");
            asm volatile("s_waitcnt vmcnt(0)" ::: "memory");
            const unsigned og = xb_add(&bar[XB_TOP], 1u);
            const unsigned tg = og / nx;
            if (og + 1u == (tg + 1u) * nx) xb_add(&bar[XB_TOPGEN], 1u);
            else XB_SPIN(xb_ld(&bar[XB_TOPGEN]) == tg, bar);
            __builtin_amdgcn_fence(__ATOMIC_ACQUIRE, "agent");
            xb_add(&bar[XB_XGEN(b.x)], 1u);
            asm volatile("s_waitcnt vmcnt(0)" ::: "memory");
        } else {
            XB_SPIN(xb_ld(&bar[XB_XGEN(b.x)]) == gen, bar);
            __builtin_amdgcn_fence(__ATOMIC_ACQUIRE, "agent");
            asm volatile("s_waitcnt vmcnt(0)" ::: "memory");
        }
    }
    __syncthreads();
}


constexpr int NPHASE = 2 + 8 * DEPTH + 1;
DI void run_phase(const Params& p, lptr lds, int ph) {
#ifdef PHASE_ONLY
    ph = PHASE_ONLY;
#endif
    if (ph == 0) { phase_p0(p, lds); return; }
    if (ph == 1) { phase_p0b(p); return; }
    if (ph == NPHASE - 1) { phase_final(p); return; }
    const int l = (ph - 2) >> 3, s = (ph - 2) & 7;
    switch (s) {
        case 0: phase_prep(p, l); break;
        case 1: phase_inproj(p, lds, l); break;
        case 2: phase_pc(p, lds, l); break;
        case 3: phase_pd(p, lds, l); break;
        case 4: phase_pe(p, lds, l); break;
        case 5: phase_outproj(p, lds, l); break;
        case 6: phase_router(p, lds, l); break;
        default: phase_moe(p, lds, l); break;
    }
}

__global__ void __launch_bounds__(NTHREADS) fwd_kernel(Params p) {
    extern __shared__ __attribute__((aligned(16))) unsigned char smem[];
    lptr lds = (lptr)smem;
    volatile LAS unsigned* st = (volatile LAS unsigned*)(lds + LDS_BYTES - 16);
    if (threadIdx.x < 4) st[threadIdx.x] = 0u;
    __syncthreads();
    const XcdBarrier bar = xcd_barrier_post((unsigned*)(p.ws + WS_BAR), st);
    for (int ph = p.ph_lo; ph < p.ph_hi; ++ph) {
        run_phase(p, lds, ph);
        if (ph + 1 < p.ph_hi) {
#if MK_CGSYNC
            asm volatile("s_waitcnt vmcnt(0) lgkmcnt(0)" ::: "memory");
            cg::this_grid().sync();
            __builtin_amdgcn_fence(__ATOMIC_ACQUIRE, "agent");
            asm volatile("s_waitcnt vmcnt(0)" ::: "memory");
#else
            xcd_barrier(bar);
#endif
        }
    }
}

extern "C" void kernel_launch(void* const* d_in, const int* in_sizes, int n_in, void* d_out, int out_size, void* d_ws, size_t ws_size, hipStream_t stream) {
    static int grid = 0;
    if (grid == 0) {
        int dev = 0, cus = 0, per_cu = 0;
        hipGetDevice(&dev);
        hipDeviceGetAttribute(&cus, hipDeviceAttributeMultiprocessorCount, dev);
        hipFuncSetAttribute((const void*)fwd_kernel, hipFuncAttributeMaxDynamicSharedMemorySize, LDS_BYTES);
        hipOccupancyMaxActiveBlocksPerMultiprocessor(&per_cu, (const void*)fwd_kernel, NTHREADS, LDS_BYTES);
        if (per_cu < 1) { fprintf(stderr, "kernel_launch: occupancy query says %d blocks/CU\n", per_cu); per_cu = 1; }
        (void)hipGetLastError();
        grid = cus > 0 ? cus : 256;
        if (ws_size < WS_END) fprintf(stderr, "kernel_launch: workspace too small: %zu < %zu\n", ws_size, (size_t)WS_END);
    }
    hipMemsetAsync((char*)d_ws, 0, WS_CTL_BYTES, stream);
    Params p{};
    const float** pp = (const float**)&p;
    for (int i = 0; i < 24; ++i) pp[i] = (const float*)d_in[i];
    p.out = (float*)d_out; p.ws = (unsigned char*)d_ws; p.pad = 0;
#if MK_MULTI
    p.coop = 0;
    for (int ph = 0; ph < NPHASE; ++ph) {
        p.ph_lo = ph; p.ph_hi = ph + 1;
        hipLaunchKernelGGL(fwd_kernel, dim3(grid), dim3(NTHREADS), LDS_BYTES, stream, p);
    }
#elif defined(MK_CUTS)
    {
        const int cuts[] = {0, MK_CUTS, NPHASE};
        const int nc = (int)(sizeof(cuts) / sizeof(int));
        p.coop = 1;
        for (int i = 0; i + 1 < nc; ++i) {
            p.ph_lo = cuts[i]; p.ph_hi = cuts[i + 1];
            if (i > 0) hipMemsetAsync((char*)d_ws + WS_BAR, 0, WS_CTL_BYTES - WS_BAR, stream);
            hipLaunchKernelGGL(fwd_kernel, dim3(grid), dim3(NTHREADS), LDS_BYTES, stream, p);
        }
    }
#else
    p.coop = 1; p.ph_lo = 0; p.ph_hi = NPHASE;
    void* args[] = {&p};
    hipError_t e = hipLaunchCooperativeKernel((const void*)fwd_kernel, dim3(grid), dim3(NTHREADS), args, LDS_BYTES, stream);
    if (e != hipSuccess) fprintf(stderr, "cooperative launch failed: %s (grid %d)\n", hipGetErrorString(e), grid);
#endif
}
```
